# Optimizing an MI355X kernel written in HIP

```python
import jax, jax.numpy as jnp
from jax import lax
import numpy as np

D_MODEL = 4096
BATCH = 2
SEQ = 8192
DEPTH = 2

N_MIXERS = 2
NORM_EPS = 1e-6
INNER_NORM_EPS = 1e-5
D_FF = -(-8 * D_MODEL // (3 * 256)) * 256

SSD_EXPAND = 2
SSD_D_INNER = SSD_EXPAND * D_MODEL
SSD_HEAD_DIM = 64
SSD_N_HEADS = SSD_D_INNER // SSD_HEAD_DIM
SSD_N_GROUPS = 8
SSD_HEADS_PER_GROUP = SSD_N_HEADS // SSD_N_GROUPS
SSD_D_STATE = 128
SSD_D_CONV = 4
SSD_CHUNK = 256
SSD_BC_DIM = SSD_N_GROUPS * SSD_D_STATE
SSD_CONV_DIM = SSD_D_INNER + 2 * SSD_BC_DIM
SSD_IN_DIM = SSD_D_INNER + SSD_CONV_DIM + SSD_N_HEADS

GLA_KEY_DIM = D_MODEL // 2
GLA_VALUE_DIM = D_MODEL
GLA_HEAD_K = 256
GLA_N_HEADS = GLA_KEY_DIM // GLA_HEAD_K
GLA_HEAD_V = GLA_VALUE_DIM // GLA_N_HEADS
GLA_GATE_RANK = 16
GLA_GATE_NORMALIZER = 16.0
GLA_CHUNK = 64
GLA_IN_DIM = 2 * GLA_KEY_DIM + 2 * GLA_VALUE_DIM + GLA_GATE_RANK

kernel_name = 'hybrid_ssd_gla_trunk'


def rms_norm(x, w, eps):
    xf = x.astype(jnp.float32)
    y = xf * lax.rsqrt(jnp.mean(xf * xf, axis=-1, keepdims=True) + eps)
    return (y * w.astype(jnp.float32)).astype(x.dtype)


def to_chunks(t, chunk):
    bsz, seqlen = t.shape[:2]
    n_pad = (-seqlen) % chunk
    t = jnp.pad(t, [(0, 0), (0, n_pad)] + [(0, 0)] * (t.ndim - 2))
    t = t.reshape(bsz, (seqlen + n_pad) // chunk, chunk, *t.shape[2:])
    return jnp.moveaxis(t, 1, 0)


def from_chunks(t, seqlen):
    t = jnp.moveaxis(t, 0, 1)
    t = t.reshape(t.shape[0], t.shape[1] * t.shape[2], *t.shape[3:])
    return t[:, :seqlen]


def causal_depthwise_conv(u, w, b):
    seqlen = u.shape[1]
    k = w.shape[1]
    up = jnp.pad(u, ((0, 0), (k - 1, 0), (0, 0)))
    out = up[:, 0:seqlen] * w[:, 0]
    for j in range(1, k):
        out = out + up[:, j:j + seqlen] * w[:, j]
    return out + b


def ssd_chunked_scan(x, dt, a, b_in, c_in):
    bsz, seqlen = x.shape[:2]
    log_a = dt * a
    xdt = x * dt[..., None]
    xs_c = to_chunks(xdt, SSD_CHUNK)
    la_c = to_chunks(log_a, SSD_CHUNK)
    b_c = to_chunks(b_in, SSD_CHUNK)
    c_c = to_chunks(c_in, SSD_CHUNK)
    causal = jnp.tril(jnp.ones((SSD_CHUNK, SSD_CHUNK), dtype=bool))[None, :, :, None, None]

    def step(state, inp):
        xc, lac, bc, cc = inp
        cs = jnp.cumsum(lac, axis=1)
        seg = cs[:, :, None] - cs[:, None, :]
        decay = jnp.exp(jnp.where(causal, seg, -jnp.inf))
        cb = jnp.einsum('blgn,bsgn->blsg', cc, bc)
        y_diag = jnp.einsum('blsg,blsgr,bsgrp->blgrp', cb, decay, xc)
        y_off = jnp.einsum('blgn,bgrpn,blgr->blgrp', cc, state, jnp.exp(cs))
        cs_end = cs[:, -1]
        decay_end = jnp.exp(cs_end[:, None] - cs)
        new_state = state * jnp.exp(cs_end)[..., None, None] + jnp.einsum(
            'blgn,blgr,blgrp->bgrpn', bc, decay_end, xc)
        return new_state, y_diag + y_off

    state0 = jnp.zeros((bsz, SSD_N_GROUPS, SSD_HEADS_PER_GROUP, SSD_HEAD_DIM, SSD_D_STATE), jnp.float32)
    _, y_c = lax.scan(step, state0, (xs_c, la_c, b_c, c_c))
    return from_chunks(y_c, seqlen)


def ssd_mixer(h, in_proj, conv_w, conv_b, dt_bias, a_log, d_skip, norm_w, out_proj):
    bsz, seqlen, _ = h.shape
    f32 = jnp.float32
    zxbcdt = h @ in_proj
    z, xbc, dt_raw = jnp.split(zxbcdt, [SSD_D_INNER, SSD_D_INNER + SSD_CONV_DIM], axis=-1)
    xbc = jax.nn.silu(causal_depthwise_conv(xbc, conv_w, conv_b))
    xs, b_in, c_in = jnp.split(xbc, [SSD_D_INNER, SSD_D_INNER + SSD_BC_DIM], axis=-1)
    xs = xs.astype(f32).reshape(bsz, seqlen, SSD_N_GROUPS, SSD_HEADS_PER_GROUP, SSD_HEAD_DIM)
    b_in = b_in.astype(f32).reshape(bsz, seqlen, SSD_N_GROUPS, SSD_D_STATE)
    c_in = c_in.astype(f32).reshape(bsz, seqlen, SSD_N_GROUPS, SSD_D_STATE)
    dt = jax.nn.softplus(dt_raw.astype(f32) + dt_bias.astype(f32))
    dt = dt.reshape(bsz, seqlen, SSD_N_GROUPS, SSD_HEADS_PER_GROUP)
    a = -jnp.exp(a_log.astype(f32)).reshape(SSD_N_GROUPS, SSD_HEADS_PER_GROUP)
    y = ssd_chunked_scan(xs, dt, a, b_in, c_in)
    y = y + xs * d_skip.astype(f32).reshape(SSD_N_GROUPS, SSD_HEADS_PER_GROUP, 1)
    y = y.reshape(bsz, seqlen, SSD_D_INNER) * jax.nn.silu(z.astype(f32))
    y = rms_norm(y.reshape(bsz, seqlen, SSD_N_GROUPS, SSD_D_INNER // SSD_N_GROUPS),
                 norm_w.reshape(SSD_N_GROUPS, SSD_D_INNER // SSD_N_GROUPS), INNER_NORM_EPS)
    y = y.reshape(bsz, seqlen, SSD_D_INNER)
    return y.astype(h.dtype) @ out_proj


def gla_chunked_scan(q, k, v, log_g):
    bsz, seqlen = q.shape[:2]
    q_c = to_chunks(q, GLA_CHUNK)
    k_c = to_chunks(k, GLA_CHUNK)
    v_c = to_chunks(v, GLA_CHUNK)
    g_c = to_chunks(log_g, GLA_CHUNK)
    causal = jnp.tril(jnp.ones((GLA_CHUNK, GLA_CHUNK), dtype=bool))[None, None]

    def step(state, inp):
        qc, kc, vc, gc = inp
        cs = jnp.cumsum(gc, axis=1)
        q_dec = qc * jnp.exp(cs)
        k_inv = kc * jnp.exp(-cs)
        scores = jnp.where(causal, jnp.einsum('blhd,bshd->bhls', q_dec, k_inv), 0.0)
        o = jnp.einsum('bhls,bshv->blhv', scores, vc) + jnp.einsum('blhd,bhdv->blhv', q_dec, state)
        cs_end = cs[:, -1]
        k_end = kc * jnp.exp(cs_end[:, None] - cs)
        new_state = state * jnp.exp(cs_end)[..., None] + jnp.einsum('blhd,blhv->bhdv', k_end, vc)
        return new_state, o

    state0 = jnp.zeros((bsz, GLA_N_HEADS, GLA_HEAD_K, GLA_HEAD_V), jnp.float32)
    _, o_c = lax.scan(step, state0, (q_c, k_c, v_c, g_c))
    return from_chunks(o_c, seqlen)


def gla_mixer(h, in_proj, gk_up, gk_bias, norm_w, out_proj):
    bsz, seqlen, _ = h.shape
    f32 = jnp.float32
    proj = h @ in_proj
    q, k, v, g, gk_low = jnp.split(
        proj, [GLA_KEY_DIM, 2 * GLA_KEY_DIM, 2 * GLA_KEY_DIM + GLA_VALUE_DIM,
               2 * GLA_KEY_DIM + 2 * GLA_VALUE_DIM], axis=-1)
    log_g = jax.nn.log_sigmoid((gk_low @ gk_up + gk_bias).astype(f32)) / GLA_GATE_NORMALIZER
    q = q.astype(f32).reshape(bsz, seqlen, GLA_N_HEADS, GLA_HEAD_K) * (GLA_HEAD_K ** -0.5)
    k = k.astype(f32).reshape(bsz, seqlen, GLA_N_HEADS, GLA_HEAD_K)
    v = v.astype(f32).reshape(bsz, seqlen, GLA_N_HEADS, GLA_HEAD_V)
    log_g = log_g.reshape(bsz, seqlen, GLA_N_HEADS, GLA_HEAD_K)
    o = gla_chunked_scan(q, k, v, log_g)
    o = rms_norm(o, norm_w, INNER_NORM_EPS)
    o = o * jax.nn.silu(g.astype(f32).reshape(bsz, seqlen, GLA_N_HEADS, GLA_HEAD_V))
    return o.reshape(bsz, seqlen, GLA_VALUE_DIM).astype(h.dtype) @ out_proj


def swiglu_ffn(h, w_gate, w_up, w_down):
    return (jax.nn.silu(h @ w_gate) * (h @ w_up)) @ w_down


def setup_inputs(seed: int = 0) -> dict:
    key = jax.random.key(seed)
    ks = jax.random.split(key, 32)
    f32 = jnp.float32

    def nrm(k, shape, scale):
        return jax.random.normal(k, shape, f32) * scale

    def gain(k, n):
        return 1.0 + 0.01 * jax.random.normal(k, (n,), f32)

    dt0 = jnp.exp(jax.random.uniform(ks[5], (SSD_N_HEADS,), f32,
                                     minval=float(np.log(1e-3)), maxval=float(np.log(1e-1))))
    return {
        'x': jax.random.normal(ks[0], (BATCH, SEQ, D_MODEL), f32),
        'l0_mixer_norm': gain(ks[1], D_MODEL),
        'l0_ssd_in_proj': nrm(ks[2], (D_MODEL, SSD_IN_DIM), D_MODEL ** -0.5),
        'l0_ssd_conv_w': nrm(ks[3], (SSD_CONV_DIM, SSD_D_CONV), SSD_D_CONV ** -0.5),
        'l0_ssd_conv_b': nrm(ks[4], (SSD_CONV_DIM,), 0.01),
        'l0_ssd_dt_bias': dt0 + jnp.log(-jnp.expm1(-dt0)),
        'l0_ssd_a_log': jnp.log(jax.random.uniform(ks[6], (SSD_N_HEADS,), f32, minval=1.0, maxval=16.0)),
        'l0_ssd_d': 1.0 + 0.1 * jax.random.normal(ks[7], (SSD_N_HEADS,), f32),
        'l0_ssd_norm_w': gain(ks[8], SSD_D_INNER),
        'l0_ssd_out_proj': nrm(ks[9], (SSD_D_INNER, D_MODEL), SSD_D_INNER ** -0.5),
        'l0_ffn_norm': gain(ks[10], D_MODEL),
        'l0_ffn_w_gate': nrm(ks[11], (D_MODEL, D_FF), D_MODEL ** -0.5),
        'l0_ffn_w_up': nrm(ks[12], (D_MODEL, D_FF), D_MODEL ** -0.5),
        'l0_ffn_w_down': nrm(ks[13], (D_FF, D_MODEL), D_FF ** -0.5),
        'l1_mixer_norm': gain(ks[14], D_MODEL),
        'l1_gla_in_proj': nrm(ks[15], (D_MODEL, GLA_IN_DIM), D_MODEL ** -0.5),
        'l1_gla_gk_up': nrm(ks[16], (GLA_GATE_RANK, GLA_KEY_DIM), GLA_GATE_RANK ** -0.5),
        'l1_gla_gk_bias': nrm(ks[17], (GLA_KEY_DIM,), 0.01),
        'l1_gla_norm_w': gain(ks[18], GLA_HEAD_V),
        'l1_gla_out_proj': nrm(ks[19], (GLA_VALUE_DIM, D_MODEL), GLA_VALUE_DIM ** -0.5),
        'l1_ffn_norm': gain(ks[20], D_MODEL),
        'l1_ffn_w_gate': nrm(ks[21], (D_MODEL, D_FF), D_MODEL ** -0.5),
        'l1_ffn_w_up': nrm(ks[22], (D_MODEL, D_FF), D_MODEL ** -0.5),
        'l1_ffn_w_down': nrm(ks[23], (D_FF, D_MODEL), D_FF ** -0.5),
        'final_norm': gain(ks[24], D_MODEL),
    }


def reference(x,
              l0_mixer_norm, l0_ssd_in_proj, l0_ssd_conv_w, l0_ssd_conv_b, l0_ssd_dt_bias,
              l0_ssd_a_log, l0_ssd_d, l0_ssd_norm_w, l0_ssd_out_proj,
              l0_ffn_norm, l0_ffn_w_gate, l0_ffn_w_up, l0_ffn_w_down,
              l1_mixer_norm, l1_gla_in_proj, l1_gla_gk_up, l1_gla_gk_bias, l1_gla_norm_w,
              l1_gla_out_proj,
              l1_ffn_norm, l1_ffn_w_gate, l1_ffn_w_up, l1_ffn_w_down,
              final_norm):
    layers = (
        (l0_mixer_norm,
         (l0_ssd_in_proj, l0_ssd_conv_w, l0_ssd_conv_b, l0_ssd_dt_bias, l0_ssd_a_log,
          l0_ssd_d, l0_ssd_norm_w, l0_ssd_out_proj),
         l0_ffn_norm, (l0_ffn_w_gate, l0_ffn_w_up, l0_ffn_w_down)),
        (l1_mixer_norm,
         (l1_gla_in_proj, l1_gla_gk_up, l1_gla_gk_bias, l1_gla_norm_w, l1_gla_out_proj),
         l1_ffn_norm, (l1_ffn_w_gate, l1_ffn_w_up, l1_ffn_w_down)),
    )
    for i in range(DEPTH):
        mixer_norm, mixer_params, ffn_norm, ffn_params = layers[i]
        h = rms_norm(x, mixer_norm, NORM_EPS)
        if i % N_MIXERS == 0:
            x = x + ssd_mixer(h, *mixer_params)
        else:
            x = x + gla_mixer(h, *mixer_params)
        x = x + swiglu_ffn(rms_norm(x, ffn_norm, NORM_EPS), *ffn_params)
    return rms_norm(x, final_norm, NORM_EPS)
```

```cpp
#include <hip/hip_runtime.h>
#include <cstdio>
#include <cstdint>
namespace pg8 {
#define PG8_LAS __attribute__((address_space(3)))
typedef unsigned short bf16_t;
typedef short bf16x8 __attribute__((ext_vector_type(8)));
typedef float f32x4 __attribute__((ext_vector_type(4)));
typedef unsigned u32x4 __attribute__((ext_vector_type(4)));
constexpr int BM = 256, BK = 64, HALF = 128, HTB = HALF * BK * 2  , STAGE_BYTES = 8 * HTB, NXCD = 8, WGM = 8;

__host__ __device__ __forceinline__ int lds_byte(int r, int c) { const int st = (r >> 4) * 2 + (c >> 5), rr = r & 15, cc = c & 31, ob = rr * 64 + cc * 2; return st * 1024 + (ob ^ (((ob >> 9) & 1) << 5)); }
__host__ __device__ __forceinline__ void stage_rc(int b, int& R, int& C) { const int st = b / 1024, sb = b % 1024, swz = sb ^ (((sb >> 9) & 1) << 5); R = (st >> 1) * 16 + swz / 64; C = (st & 1) * 32 + (swz % 64) / 2; }
__host__ __device__ __forceinline__ int perm32(int rho) { const int n = rho >> 4, i = rho & 15; return 8 * (i >> 2) + 4 * n + (i & 3); }

struct Unit { int pm, pn; };
struct Gemm { const bf16_t* A; const bf16_t* Bt; int M, N, K; };

struct StaticOrder {
    int nM, nN, nwg, G, c;
    __host__ __device__ void init(int M, int N, int G_, int c_) { nM = M / BM; nN = N / BM; nwg = nM * nN; G = G_; c = c_; }
    __host__ __device__ bool next(int i, Unit& u) const {
        const long L = (long)i * G + c; if (L >= nwg) return false;
        int wgid = (int)L; { const int q = nwg / NXCD, r = nwg % NXCD, xcd = wgid % NXCD, off = wgid / NXCD; wgid = (xcd < r ? xcd * (q + 1) : r * (q + 1) + (xcd - r) * q) + off; }
        const int nig = WGM * nN, gid = wgid / nig, fm = gid * WGM, gsz = (nM - fm) < WGM ? (nM - fm) : WGM;
        u.pm = fm + ((wgid % nig) % gsz); u.pn = (wgid % nig) / gsz; return true;
    }
    __device__ __forceinline__ void a_ready(const Unit&) const {}
    __device__ __forceinline__ void done(const Unit&) const {}
};
__device__ __forceinline__ unsigned cvt_pk_bf16(float lo, float hi) { unsigned r; asm volatile("v_cvt_pk_bf16_f32 %0, %1, %2" : "=v"(r) : "v"(lo), "v"(hi)); return r; }
typedef float f32x2 __attribute__((ext_vector_type(2)));
__device__ __forceinline__ float silu_f(float v) { return v * __builtin_amdgcn_rcpf(1.0f + __builtin_amdgcn_exp2f(-1.44269504f * v)); }
__device__ __forceinline__ u32x4 pack8(const f32x4 v0, const f32x4 v1) { u32x4 w; w.x = cvt_pk_bf16(v0[0], v0[1]); w.y = cvt_pk_bf16(v0[2], v0[3]); w.z = cvt_pk_bf16(v1[0], v1[1]); w.w = cvt_pk_bf16(v1[2], v1[3]); return w; }

struct EpiSsdIn {
    static constexpr bool PERM = true, AFTER_DRAIN = false;
    bf16_t* Z; bf16_t* XBC; float* DT;
    __device__ __forceinline__ void operator()(const f32x4 (&acc)[2][2][4][2], const Unit& u, int wr, int wc, int fr, int fq) const {
        const int row0 = u.pm * BM + wr * 64 + fr;
        if (u.pn < 72) {
            bf16_t* base; int ldc, colt;
            if (u.pn < 32) { base = Z; ldc = 8192; colt = u.pn * BM; } else { base = XBC; ldc = 10240; colt = (u.pn - 32) * BM; }
            const int col0 = colt + wc * 32 + 8 * fq;
#pragma unroll
            for (int ai = 0; ai < 2; ++ai)
#pragma unroll
                for (int m = 0; m < 4; ++m) { bf16_t* rowp = base + (size_t)(row0 + ai * HALF + m * 16) * ldc + col0;
#pragma unroll
                    for (int bj = 0; bj < 2; ++bj) *(u32x4*)(rowp + bj * HALF) = pack8(acc[ai][bj][m][0], acc[ai][bj][m][1]); }
        } else {
            const int col0 = wc * 32 + 8 * fq;
#pragma unroll
            for (int ai = 0; ai < 2; ++ai)
#pragma unroll
                for (int m = 0; m < 4; ++m) { float* rowp = DT + (size_t)(row0 + ai * HALF + m * 16) * 128 + col0;
                    *(f32x4*)rowp = acc[ai][0][m][0]; *(f32x4*)(rowp + 4) = acc[ai][0][m][1]; }
        }
    }
};
struct EpiGlaIn {
    static constexpr bool PERM = true, AFTER_DRAIN = false;
    bf16_t* PROJ; float* GKL;
    __device__ __forceinline__ void operator()(const f32x4 (&acc)[2][2][4][2], const Unit& u, int wr, int wc, int fr, int fq) const {
        const int row0 = u.pm * BM + wr * 64 + fr;
        if (u.pn < 48) {
            const int col0 = u.pn * BM + wc * 32 + 8 * fq;
#pragma unroll
            for (int ai = 0; ai < 2; ++ai)
#pragma unroll
                for (int m = 0; m < 4; ++m) { bf16_t* rowp = PROJ + (size_t)(row0 + ai * HALF + m * 16) * 12288 + col0;
#pragma unroll
                    for (int bj = 0; bj < 2; ++bj) *(u32x4*)(rowp + bj * HALF) = pack8(acc[ai][bj][m][0], acc[ai][bj][m][1]); }
        } else if (wc == 0 && fq < 2) {
#pragma unroll
            for (int ai = 0; ai < 2; ++ai)
#pragma unroll
                for (int m = 0; m < 4; ++m) { float* rowp = GKL + (size_t)(row0 + ai * HALF + m * 16) * 16 + 8 * fq;
                    *(f32x4*)rowp = acc[ai][0][m][0]; *(f32x4*)(rowp + 4) = acc[ai][0][m][1]; }
        }
    }
};
struct EpiResF32 {
    static constexpr bool PERM = false, AFTER_DRAIN = false;
    const float* base; float* out; int ldc;
    __device__ __forceinline__ void operator()(const f32x4 (&acc)[2][2][4][2], const Unit& u, int wr, int wc, int fr, int fq) const {
        const int row0 = u.pm * BM + wr * 64 + fr, col0 = u.pn * BM + wc * 32 + 4 * fq;
#pragma unroll
        for (int ai = 0; ai < 2; ++ai)
#pragma unroll
            for (int m = 0; m < 4; ++m) { const size_t off = (size_t)(row0 + ai * HALF + m * 16) * ldc + col0;
#pragma unroll
                for (int bj = 0; bj < 2; ++bj)
#pragma unroll
                    for (int n = 0; n < 2; ++n) { const f32x4 b = *(const f32x4*)(base + off + bj * HALF + n * 16); *(f32x4*)(out + off + bj * HALF + n * 16) = b + acc[ai][bj][m][n]; } }
    }
};
struct EpiSwiGLU {
    static constexpr bool PERM = true, AFTER_DRAIN = false;
    bf16_t* O; int ldc;
    __device__ __forceinline__ void operator()(const f32x4 (&acc)[2][2][4][2], const Unit& u, int wr, int wc, int fr, int fq) const {
        const int row0 = u.pm * BM + wr * 64 + fr, col0 = u.pn * HALF + wc * 32 + 8 * fq;
#pragma unroll
        for (int ai = 0; ai < 2; ++ai)
#pragma unroll
            for (int m = 0; m < 4; ++m) { bf16_t* rowp = O + (size_t)(row0 + ai * HALF + m * 16) * ldc + col0;
                f32x4 v0, v1;
#pragma unroll
                for (int j = 0; j < 4; ++j) { v0[j] = silu_f(acc[ai][0][m][0][j]) * acc[ai][1][m][0][j]; v1[j] = silu_f(acc[ai][0][m][1][j]) * acc[ai][1][m][1][j]; }
                *(u32x4*)rowp = pack8(v0, v1); }
    }
};
template <class Epi, class Sched, bool ALIGN_EPI = false, bool SP2 = false>
__device__ __forceinline__ void gemm_phase(PG8_LAS unsigned char* lds, const Gemm g, const Sched& S, const Epi& E) {
    const int tid = threadIdx.x, wid = __builtin_amdgcn_readfirstlane(tid >> 6), lane = tid & 63, wr = wid >> 2, wc = wid & 3, fr = lane & 15, fq = lane >> 4;
    const int K = g.K, nt = K / BK;
    unsigned voffA[2], voffB[2];
#pragma unroll
    for (int i = 0; i < 2; ++i) { int R, C; stage_rc(tid * 16 + i * 8192, R, C); const int Rb = Epi::PERM ? ((R & ~31) + perm32(R & 31)) : R;
        voffA[i] = (unsigned)(R * K + C) * 2u; voffB[i] = (unsigned)(Rb * K + C) * 2u; }
    const size_t kstep = (size_t)(BK * 2);
    const size_t hstep = (size_t)HALF * K * 2;
    const size_t tstep = 2 * hstep;
    const unsigned ldsw = (unsigned)wid * 1024u;
    const int aoff = lds_byte(wr * 64 + fr, fq * 8), boff = lds_byte(wc * 32 + fr, fq * 8);
#define PG8_SA(b, h) (((b) * 2 + (h)) * HTB)
#define PG8_SB(b, h) ((4 + (b) * 2 + (h)) * HTB)
#define PG8_STAGE(bufoff, gbase, voff) do { _Pragma("unroll") for (int _i = 0; _i < 2; ++_i) \
        __builtin_amdgcn_global_load_lds((const unsigned*)((const char*)(gbase) + (voff)[_i]), (PG8_LAS unsigned*)(lds + (bufoff) + ldsw + _i * 8192), 16, 0, 0); } while (0)
#define PG8_LDA(dst, b, h) do { _Pragma("unroll") for (int m = 0; m < 4; ++m) _Pragma("unroll") for (int k = 0; k < 2; ++k) dst[m][k] = *(const PG8_LAS bf16x8*)(lds + PG8_SA(b, h) + aoff + m * 2048 + k * 1024); } while (0)
#define PG8_LDB(dst, b, h) do { _Pragma("unroll") for (int n = 0; n < 2; ++n) _Pragma("unroll") for (int k = 0; k < 2; ++k) dst[n][k] = *(const PG8_LAS bf16x8*)(lds + PG8_SB(b, h) + boff + n * 2048 + k * 1024); } while (0)
#define PG8_MMA(ai, bj, At, Bt) do { __builtin_amdgcn_s_setprio(1); _Pragma("unroll") for (int m = 0; m < 4; ++m) _Pragma("unroll") for (int n = 0; n < 2; ++n) _Pragma("unroll") for (int k = 0; k < 2; ++k) \
        acc[ai][bj][m][n] = __builtin_amdgcn_mfma_f32_16x16x32_bf16(Bt[n][k], At[m][k], acc[ai][bj][m][n], 0, 0, 0); __builtin_amdgcn_s_setprio(0); } while (0)
#define PG8_WAIT_V(n) asm volatile("s_waitcnt vmcnt(" #n ")" ::: "memory")
#define PG8_WAIT_L(n) asm volatile("s_waitcnt lgkmcnt(" #n ")" ::: "memory")
#define PG8_BAR __builtin_amdgcn_s_barrier()
#define PG8_SCHED __builtin_amdgcn_sched_barrier(0)
    Unit cur, nxt; int ui = 0;
    if (!S.next(0, cur)) return;
    f32x4 acc[2][2][4][2];
#pragma unroll
    for (int a = 0; a < 2; ++a)
#pragma unroll
        for (int b = 0; b < 2; ++b)
#pragma unroll
            for (int m = 0; m < 4; ++m)
#pragma unroll
                for (int n = 0; n < 2; ++n) acc[a][b][m][n] = (f32x4){0.f, 0.f, 0.f, 0.f};
    bf16x8 At[4][2], B0[2][2], B1[2][2];
    const char* cA = (const char*)g.A + (size_t)cur.pm * tstep; const char* cB = (const char*)g.Bt + (size_t)cur.pn * tstep;
    S.a_ready(cur);
    if constexpr (SP2) {
        PG8_STAGE(PG8_SB(0, 0), cB, voffB); PG8_STAGE(PG8_SB(0, 1), cB + hstep, voffB); PG8_STAGE(PG8_SA(0, 0), cA, voffA); PG8_STAGE(PG8_SA(0, 1), cA + hstep, voffA);
        if (wr == 1) PG8_BAR;
        PG8_WAIT_V(2); PG8_BAR;
        PG8_STAGE(PG8_SB(1, 0), cB + kstep, voffB); PG8_STAGE(PG8_SA(1, 0), cA + kstep, voffA); PG8_STAGE(PG8_SB(1, 1), cB + hstep + kstep, voffB);
        PG8_WAIT_V(6); PG8_BAR;
    } else {
        PG8_STAGE(PG8_SB(0, 0), cB, voffB); PG8_STAGE(PG8_SA(0, 0), cA, voffA); PG8_STAGE(PG8_SB(0, 1), cB + hstep, voffB); PG8_STAGE(PG8_SA(0, 1), cA + hstep, voffA);
        if (wr == 1) PG8_BAR;
        PG8_WAIT_V(4); PG8_BAR;
        PG8_STAGE(PG8_SB(1, 0), cB + kstep, voffB); PG8_STAGE(PG8_SA(1, 0), cA + kstep, voffA); PG8_STAGE(PG8_SB(1, 1), cB + hstep + kstep, voffB);
        PG8_WAIT_V(6); PG8_BAR;
    }
    for (;;) {
        const bool has_next = S.next(ui + 1, nxt);
        const char* nA = has_next ? (const char*)g.A + (size_t)nxt.pm * tstep : cA; const char* nB = has_next ? (const char*)g.Bt + (size_t)nxt.pn * tstep : cB;
        for (int t = 0; t < nt; t += 2) {
            const bool last = (t == nt - 2);
            const char* a1 = cA + (size_t)(t + 1) * kstep;
            const char* a2 = last ? nA : cA + (size_t)(t + 2) * kstep; const char* b2 = last ? nB : cB + (size_t)(t + 2) * kstep;
            const char* a3 = a2 + kstep; const char* b3 = b2 + kstep;
            if (last && has_next) S.a_ready(nxt);
            if constexpr (SP2) {
            PG8_LDB(B0, 0, 0); PG8_LDB(B1, 0, 1); PG8_SCHED; PG8_LDA(At, 0, 0); PG8_STAGE(PG8_SA(1, 1), a1 + hstep, voffA);
            PG8_WAIT_V(8); PG8_WAIT_L(0); PG8_BAR; PG8_MMA(0, 0, At, B0); PG8_MMA(0, 1, At, B1); PG8_BAR; PG8_SCHED;
            PG8_LDA(At, 0, 1); PG8_STAGE(PG8_SB(0, 0), b2, voffB); PG8_STAGE(PG8_SB(0, 1), b2 + hstep, voffB); PG8_STAGE(PG8_SA(0, 0), a2, voffA);
            PG8_WAIT_V(8); PG8_WAIT_L(0); PG8_BAR; PG8_MMA(1, 0, At, B0); PG8_MMA(1, 1, At, B1); PG8_BAR; PG8_SCHED;
            PG8_LDB(B0, 1, 0); PG8_LDB(B1, 1, 1); PG8_SCHED; PG8_LDA(At, 1, 0); PG8_STAGE(PG8_SA(0, 1), a2 + hstep, voffA);
            PG8_WAIT_V(8); PG8_WAIT_L(0); PG8_BAR; PG8_MMA(0, 0, At, B0); PG8_MMA(0, 1, At, B1); PG8_BAR; PG8_SCHED;
            PG8_LDA(At, 1, 1); PG8_STAGE(PG8_SB(1, 0), b3, voffB); PG8_STAGE(PG8_SB(1, 1), b3 + hstep, voffB); PG8_STAGE(PG8_SA(1, 0), a3, voffA);
            PG8_WAIT_V(8); PG8_WAIT_L(0); PG8_BAR; PG8_MMA(1, 0, At, B0); PG8_MMA(1, 1, At, B1); PG8_BAR; PG8_SCHED;
            } else {
            PG8_LDB(B0, 0, 0); PG8_SCHED; PG8_LDA(At, 0, 0); PG8_STAGE(PG8_SA(1, 1), a1 + hstep, voffA);
            PG8_WAIT_L(8); PG8_BAR; PG8_WAIT_L(0); PG8_MMA(0, 0, At, B0); PG8_BAR; PG8_SCHED;
            PG8_LDB(B1, 0, 1); PG8_STAGE(PG8_SB(0, 0), b2, voffB);
            PG8_BAR; PG8_WAIT_L(0); PG8_MMA(0, 1, At, B1); PG8_BAR;
            PG8_LDA(At, 0, 1); PG8_STAGE(PG8_SA(0, 0), a2, voffA);
            PG8_BAR; PG8_WAIT_L(0); PG8_MMA(1, 0, At, B0); PG8_BAR; PG8_SCHED;
            PG8_STAGE(PG8_SB(0, 1), b2 + hstep, voffB);
            PG8_WAIT_V(6); PG8_BAR; PG8_MMA(1, 1, At, B1); PG8_BAR;
            PG8_LDB(B0, 1, 0); PG8_SCHED; PG8_LDA(At, 1, 0); PG8_STAGE(PG8_SA(0, 1), a2 + hstep, voffA);
            PG8_WAIT_L(8); PG8_BAR; PG8_WAIT_L(0); PG8_MMA(0, 0, At, B0); PG8_BAR; PG8_SCHED;
            PG8_LDB(B1, 1, 1); PG8_STAGE(PG8_SB(1, 0), b3, voffB);
            PG8_BAR; PG8_WAIT_L(0); PG8_MMA(0, 1, At, B1); PG8_BAR;
            PG8_LDA(At, 1, 1); PG8_STAGE(PG8_SA(1, 0), a3, voffA);
            PG8_BAR; PG8_WAIT_L(0); PG8_MMA(1, 0, At, B0); PG8_BAR; PG8_SCHED;
            PG8_STAGE(PG8_SB(1, 1), b3 + hstep, voffB);
            PG8_WAIT_V(6); PG8_BAR; PG8_MMA(1, 1, At, B1); PG8_BAR;
            }
        }
        if constexpr (ALIGN_EPI) { if (wr == 0) PG8_BAR; }
        if constexpr (!Epi::AFTER_DRAIN) { E(acc, cur, wr, wc, fr, fq); S.done(cur); }
        if (!has_next) break;
#pragma unroll
        for (int a = 0; a < 2; ++a)
#pragma unroll
            for (int b = 0; b < 2; ++b)
#pragma unroll
                for (int m = 0; m < 4; ++m)
#pragma unroll
                    for (int n = 0; n < 2; ++n) acc[a][b][m][n] = (f32x4){0.f, 0.f, 0.f, 0.f};
        cur = nxt; cA = nA; cB = nB; ++ui;
        if constexpr (ALIGN_EPI) { if (wr == 1) PG8_BAR; }
    }
    PG8_WAIT_V(0);
    if constexpr (!ALIGN_EPI) { if (wr == 0) PG8_BAR; }
    PG8_BAR;
    if constexpr (Epi::AFTER_DRAIN) { E.fused(acc, cur, wr, wc, fr, fq, lds, wid, lane); S.done(cur); }
#undef PG8_SA
#undef PG8_SB
#undef PG8_STAGE
#undef PG8_LDA
#undef PG8_LDB
#undef PG8_MMA
#undef PG8_WAIT_V
#undef PG8_WAIT_L
#undef PG8_BAR
#undef PG8_SCHED
}
}
#define GAS __attribute__((address_space(1)))
#define LAS __attribute__((address_space(3)))
typedef unsigned short bf16;
typedef unsigned v4u __attribute__((ext_vector_type(4)));
typedef float f32x4 __attribute__((ext_vector_type(4)));
typedef short bf16x8 __attribute__((ext_vector_type(8)));
typedef GAS unsigned gu32;
typedef GAS unsigned long long gu64;
#define RLX_AGENT __ATOMIC_RELAXED, __HIP_MEMORY_SCOPE_AGENT
#define LDS_WAIT() asm volatile("s_waitcnt lgkmcnt(0)" ::: "memory")
#define VM_WAIT() asm volatile("s_waitcnt vmcnt(0)" ::: "memory")
__device__ __forceinline__ unsigned long long rt() { return __builtin_amdgcn_s_memrealtime(); }
__device__ __forceinline__ unsigned f2bf(float f) { unsigned u = __builtin_bit_cast(unsigned, f); return (u + 0x7fffu + ((u >> 16) & 1u)) >> 16; }
__device__ __forceinline__ unsigned pk2(float lo, float hi) { return f2bf(lo) | (f2bf(hi) << 16); }

#define XB_TMO      128
#define XB_XCNT(j)  (256  + 64 * (j))
#define XB_XSUB(j)  (1280 + 64 * (j))
#define XB_XGEN(j)  (2304 + 64 * (j))
#define XB_TOP      3328
#define XB_TOPGEN   3392
#define XCD_BAR_WORDS 3456
#define XB_SPIN_CAP (1u << 18)

__device__ __forceinline__ unsigned xb_ld(unsigned* p)              { return __hip_atomic_load(p, __ATOMIC_RELAXED, __HIP_MEMORY_SCOPE_AGENT); }
__device__ __forceinline__ unsigned xb_add(unsigned* p, unsigned v) { return __hip_atomic_fetch_add(p, v, __ATOMIC_RELAXED, __HIP_MEMORY_SCOPE_AGENT); }
__device__ __forceinline__ unsigned xb_xcc_id() { return (unsigned)__builtin_amdgcn_s_getreg((3 << 11) | 20) & 0xFu; }
#define XB_SPIN(cond, bar) do { unsigned _sp = 0; while (cond) { __builtin_amdgcn_s_sleep(1); \
    if ((++_sp & 255u) == 0u) { if (xb_ld(&(bar)[XB_TMO])) break; if (_sp > XB_SPIN_CAP) { atomicAdd(&(bar)[XB_TMO], 1u); break; } } } } while (0)

struct XcdBarrier {
    unsigned* bar; unsigned x;
    volatile LAS unsigned* st;
};

__device__ __forceinline__ XcdBarrier xcd_barrier_post(unsigned* bar, volatile LAS unsigned* st) {
    XcdBarrier b; b.bar = bar; b.x = xb_xcc_id(); b.st = st;
    if (threadIdx.x == 0) (void)xb_add(&bar[XB_XCNT(b.x)], 1u);
    return b;
}
__device__ __forceinline__ void xcd_barrier_complete(unsigned* bar, unsigned x, unsigned& nloc, unsigned& nx) {
    const unsigned G = gridDim.x * gridDim.y * gridDim.z;
    unsigned sum, cnt, mine, sp = 0u;
    for (;;) {
        sum = 0u; cnt = 0u; mine = 0u;
#pragma unroll
        for (unsigned j = 0; j < 16; ++j) { const unsigned c = xb_ld(&bar[XB_XCNT(j)]); sum += c; cnt += (c > 0u) ? 1u : 0u; mine = (j == x) ? c : mine; }
        if (sum == G) break;
        __builtin_amdgcn_s_sleep(1);
        if ((++sp & 255u) == 0u) { if (xb_ld(&bar[XB_TMO])) break; if (sp > XB_SPIN_CAP) { atomicAdd(&bar[XB_TMO], 1u); break; } }
    }
    nloc = mine > 0u ? mine : 1u; nx = cnt > 0u ? cnt : 1u;
}

__device__ __forceinline__ void xcd_barrier(const XcdBarrier& b) {
    asm volatile("s_waitcnt vmcnt(0)" ::: "memory");
    __syncthreads();
    if (threadIdx.x == 0) {
        unsigned* bar = b.bar;
        __builtin_amdgcn_s_waitcnt(0);
        unsigned nloc = b.st[0], nx = b.st[1];
        if (nloc == 0u) { xcd_barrier_complete(bar, b.x, nloc, nx); b.st[0] = nloc; b.st[1] = nx; }
        const unsigned old = xb_add(&bar[XB_XSUB(b.x)], 1u);
        const unsigned gen = old / nloc;
        if (old + 1u == (gen + 1u) * nloc) {
            __builtin_amdgcn_fence(__ATOMIC_RELEASE, "agent");
            asm volatile("s_waitcnt vmcnt(0)" ::: "memory");
            const unsigned og = xb_add(&bar[XB_TOP], 1u);
            const unsigned tg = og / nx;
            if (og + 1u == (tg + 1u) * nx) xb_add(&bar[XB_TOPGEN], 1u);
            else XB_SPIN(xb_ld(&bar[XB_TOPGEN]) == tg, bar);
            __builtin_amdgcn_fence(__ATOMIC_ACQUIRE, "agent");
            xb_add(&bar[XB_XGEN(b.x)], 1u);
            asm volatile("s_waitcnt vmcnt(0)" ::: "memory");
        } else {
            XB_SPIN(xb_ld(&bar[XB_XGEN(b.x)]) == gen, bar);
            __builtin_amdgcn_fence(__ATOMIC_ACQUIRE, "agent");
            asm volatile("s_waitcnt vmcnt(0)" ::: "memory");
        }
    }
    __syncthreads();
}
typedef float f32x2 __attribute__((ext_vector_type(2)));
constexpr int NWAVES = 8;
#ifndef MK_SPLIT
#define MK_SPLIT 1
#endif
constexpr int NPHASE = 19;

constexpr int M = 16384, T = 8192, D = 4096, DFF = 11008, GU_N = 2 * DFF;
constexpr int S_DI = 8192, S_CONV = 10240, S_IN = 18560, S_INP = 18688;
constexpr int G_PROJ = 12288, G_IN = 12304, G_INP = 12544;
constexpr float NORM_EPS = 1e-6f, INNER_EPS = 1e-5f;

constexpr size_t MiB = 1u << 20;
constexpr size_t WS_CTL = 0, CTL_ZERO_BYTES = 1 * MiB;
constexpr size_t WS_WIN = 2 * MiB;
constexpr size_t WS_WOUT0 = 148 * MiB;
constexpr size_t WS_WOUT1 = 100 * MiB;
constexpr size_t WS_WGU = 212 * MiB;
constexpr size_t WS_WDN = 384 * MiB;
constexpr size_t WS_XN = 470 * MiB;
constexpr size_t WS_R = 598 * MiB;
constexpr size_t WS_Z = WS_R, WS_XBC = WS_R + 256 * MiB, WS_XBC2 = WS_XBC + 320 * MiB, WS_DT = WS_XBC2 + 320 * MiB, WS_SSQ = WS_DT + 8 * MiB, WS_YG = WS_XBC;
constexpr size_t WS_ACT = WS_R;
constexpr size_t WS_PROJ = WS_R, WS_GKL = WS_R + 384 * MiB, WS_E = WS_GKL + 2 * MiB, WS_O = WS_E + 128 * MiB, WS_SSQ2 = WS_O + 128 * MiB;
constexpr size_t WS_END = 1510 * MiB;
static_assert(WS_SSQ + 8 * MiB <= WS_END && WS_SSQ2 + 8 * MiB <= WS_END && WS_WIN + (size_t)S_INP * D * 2 <= WS_WOUT0 && WS_WOUT0 + (size_t)D * S_DI * 2 <= WS_WGU && WS_WGU + (size_t)GU_N * D * 2 <= WS_WDN && WS_WDN + (size_t)D * DFF * 2 <= WS_XN, "d_ws map");
static_assert(WS_WIN + (size_t)G_INP * D * 2 <= WS_WOUT1 && WS_WOUT1 + (size_t)D * D * 2 <= WS_WGU && WS_ACT + (size_t)M * DFF * 2 <= WS_O, "d_ws map 2");
constexpr int CW_BAR = 4096;

constexpr int RING_OFF = 0, RING_BYTES = 131072;
constexpr int LDSCTL_OFF = RING_BYTES, MISC_OFF = LDSCTL_OFF + 320;
constexpr int LDS_BYTES = 147456;

__device__ __forceinline__ float wave_sum(float v) {
#pragma unroll
    for (int o = 1; o < 64; o <<= 1) v += __shfl_xor(v, o);
    return v;
}
template <int CTRL> __device__ __forceinline__ float dpp_add(float v) { return v + __builtin_bit_cast(float, __builtin_amdgcn_update_dpp(0, __builtin_bit_cast(int, v), CTRL, 0xF, 0xF, true)); }
__device__ __forceinline__ float red4(float v) { v = dpp_add<0xB1>(v); v = dpp_add<0x4E>(v); return v; }
__device__ __forceinline__ float red8(float v) { v = red4(v); return dpp_add<0x141>(v); }
__device__ __forceinline__ float red16(float v) { v = red8(v); return dpp_add<0x140>(v); }
__device__ __forceinline__ float red32(float v) { v = red16(v); return v + __shfl_xor(v, 16); }
__device__ __forceinline__ void bf8_to_f32(const v4u u, float (&f)[8]) {
    f[0] = __builtin_bit_cast(float, u.x << 16); f[1] = __builtin_bit_cast(float, u.x & 0xffff0000u); f[2] = __builtin_bit_cast(float, u.y << 16); f[3] = __builtin_bit_cast(float, u.y & 0xffff0000u);
    f[4] = __builtin_bit_cast(float, u.z << 16); f[5] = __builtin_bit_cast(float, u.z & 0xffff0000u); f[6] = __builtin_bit_cast(float, u.w << 16); f[7] = __builtin_bit_cast(float, u.w & 0xffff0000u);
}
__device__ __forceinline__ float silu(float v) { return v / (1.0f + __expf(-v)); }
__device__ __forceinline__ float softplus(float x) { return fmaxf(x, 0.f) + log1pf(expf(-fabsf(x))); }

__device__ __forceinline__ void transpose_item(const float* W, int N, int K, bf16* WT, int k0, int n0, int ncols, int drow0, LAS float* scr, int lane) {
    const int nn = lane & 31; const bool ok = nn < ncols;
#pragma unroll 8
    for (int i = 0; i < 32; ++i) { const int kk = 2 * i + (lane >> 5); scr[kk * 33 + nn] = ok ? W[(size_t)(k0 + kk) * N + n0 + nn] : 0.f; }
    LDS_WAIT(); asm volatile("" ::: "memory");
    const int c = lane & 7;
#pragma unroll
    for (int j = 0; j < 4; ++j) { const int n = (lane >> 3) + 8 * j; const LAS float* s = scr + (8 * c) * 33 + n;
        v4u o; o.x = pk2(s[0 * 33], s[1 * 33]); o.y = pk2(s[2 * 33], s[3 * 33]); o.z = pk2(s[4 * 33], s[5 * 33]); o.w = pk2(s[6 * 33], s[7 * 33]);
        if (n < ncols) *(v4u*)(WT + (size_t)(drow0 + n) * K + k0 + 8 * c) = o; }
    LDS_WAIT(); asm volatile("" ::: "memory");
}
struct WJob { const float* W; bf16* WT; int K, N, mode; };
__device__ __forceinline__ int wjob_items(const WJob& j) { return (j.K / 64) * ((j.N + 31) / 32); }
__device__ __forceinline__ void wjob_item(const WJob& j, int r, LAS float* scr, int lane) {
    const int nblk = (j.N + 31) / 32, kb = r / nblk, nb = r - kb * nblk, n0 = 32 * nb, rem = j.N - n0, ncols = rem < 32 ? rem : 32;
    const int drow0 = j.mode == 0 ? n0 : ((n0 >> 7) * 256 + (n0 & 127) + (j.mode == 2 ? 128 : 0));
    transpose_item(j.W, j.N, j.K, j.WT, 64 * kb, n0, ncols, drow0, scr, lane);
}
__device__ __forceinline__ void convert_layer(const WJob& j0, const WJob& j1, const WJob& j2, const WJob& j3, const WJob& j4, LAS float* scr, int gw, int NGW, int lane) {
    const int i0 = wjob_items(j0), i1 = wjob_items(j1), i2 = wjob_items(j2), i3 = wjob_items(j3), i4 = wjob_items(j4);
    const int total = i0 + i1 + i2 + i3 + i4;
    for (int it = gw; it < total; it += NGW) {
        int r = it; WJob j = j0;
        if (r >= i0) { r -= i0; j = j1; if (r >= i1) { r -= i1; j = j2; if (r >= i2) { r -= i2; j = j3; if (r >= i3) { r -= i3; j = j4; } } } }
        wjob_item(j, r, scr, lane);
    }
}
__device__ __forceinline__ void zero_rows_bf16(bf16* p, size_t nelem, int gtid, int nthreads) {
    for (size_t i = (size_t)gtid * 8; i < nelem; i += (size_t)nthreads * 8) *(v4u*)(p + i) = (v4u){0u, 0u, 0u, 0u};
}
__device__ __forceinline__ void rmsnorm_row_bf16(const float* xrow, const float* w, bf16* orow, int lane) {
    const f32x4* xr = (const f32x4*)xrow + lane; f32x4 v[16]; float s = 0.f;
#pragma unroll
    for (int j = 0; j < 16; ++j) { v[j] = xr[64 * j]; s += (v[j].x * v[j].x + v[j].y * v[j].y) + (v[j].z * v[j].z + v[j].w * v[j].w); }
    const float rstd = 1.0f / sqrtf(wave_sum(s) * (1.f / D) + NORM_EPS);
    const f32x4* wr = (const f32x4*)w + lane; unsigned long long* o8 = (unsigned long long*)orow + lane;
#pragma unroll
    for (int j = 0; j < 16; ++j) { const f32x4 ww = wr[64 * j];
        o8[64 * j] = (unsigned long long)pk2(v[j].x * rstd * ww.x, v[j].y * rstd * ww.y) | ((unsigned long long)pk2(v[j].z * rstd * ww.z, v[j].w * rstd * ww.w) << 32); }
}
__device__ __forceinline__ void rmsnorm_row_f32(float* xrow, const float* w, int lane) {
    f32x4* xr = (f32x4*)xrow + lane; f32x4 v[16]; float s = 0.f;
#pragma unroll
    for (int j = 0; j < 16; ++j) { v[j] = xr[64 * j]; s += (v[j].x * v[j].x + v[j].y * v[j].y) + (v[j].z * v[j].z + v[j].w * v[j].w); }
    const float rstd = 1.0f / sqrtf(wave_sum(s) * (1.f / D) + NORM_EPS);
    const f32x4* wr = (const f32x4*)w + lane;
#pragma unroll
    for (int j = 0; j < 16; ++j) { const f32x4 ww = wr[64 * j]; xr[64 * j] = (f32x4){v[j].x * rstd * ww.x, v[j].y * rstd * ww.y, v[j].z * rstd * ww.z, v[j].w * rstd * ww.w}; }
}
__device__ __forceinline__ void conv_item(const bf16* XBC, bf16* XBC2, const float* cw, const float* cb, int it, int lane) {
    const int tb = it / 20, cbk = it - tb * 20, m0 = tb * 64, c0 = cbk * 512 + lane * 8;
    float w[8][4], bias[8];
#pragma unroll
    for (int i = 0; i < 8; ++i) { const f32x4 ww = *(const f32x4*)(cw + (size_t)(c0 + i) * 4); w[i][0] = ww.x; w[i][1] = ww.y; w[i][2] = ww.z; w[i][3] = ww.w; }
    { const f32x4 b0 = *(const f32x4*)(cb + c0), b1 = *(const f32x4*)(cb + c0 + 4); bias[0] = b0.x; bias[1] = b0.y; bias[2] = b0.z; bias[3] = b0.w; bias[4] = b1.x; bias[5] = b1.y; bias[6] = b1.z; bias[7] = b1.w; }
    float h0[8], h1[8], h2[8];
    const bf16* src = XBC + (size_t)m0 * S_CONV + c0; bf16* dst = XBC2 + (size_t)m0 * S_CONV + c0;
    if ((m0 % T) == 0) {
#pragma unroll
        for (int i = 0; i < 8; ++i) { h0[i] = 0.f; h1[i] = 0.f; h2[i] = 0.f; }
    } else {
        bf8_to_f32(*(const v4u*)(src - 3 * (size_t)S_CONV), h0); bf8_to_f32(*(const v4u*)(src - 2 * (size_t)S_CONV), h1); bf8_to_f32(*(const v4u*)(src - 1 * (size_t)S_CONV), h2);
    }
    for (int r0 = 0; r0 < 64; r0 += 8) {
        v4u raw[8];
#pragma unroll
        for (int r = 0; r < 8; ++r) raw[r] = *(const v4u*)(src + (size_t)(r0 + r) * S_CONV);
#pragma unroll
        for (int r = 0; r < 8; ++r) {
            float cur[8], o[8]; bf8_to_f32(raw[r], cur);
#pragma unroll
            for (int i = 0; i < 8; ++i) { const float a = bias[i] + w[i][0] * h0[i] + w[i][1] * h1[i] + w[i][2] * h2[i] + w[i][3] * cur[i]; o[i] = silu(a); h0[i] = h1[i]; h1[i] = h2[i]; h2[i] = cur[i]; }
            v4u ov; ov.x = pk2(o[0], o[1]); ov.y = pk2(o[2], o[3]); ov.z = pk2(o[4], o[5]); ov.w = pk2(o[6], o[7]);
            *(v4u*)(dst + (size_t)(r0 + r) * S_CONV) = ov;
        }
    }
}
__device__ __forceinline__ void ssd_scan_unit(LAS unsigned char* lds, int b, int h, const bf16* XBC2, const bf16* Z, const float* DTV, const float* a_log, const float* dskip, bf16* YG, float* SSQ, int tid) {
    LAS float* Bs = (LAS float*)lds;
    LAS float* Cs = Bs + 64 * 128;
    LAS float* Xs = Cs + 64 * 128;
    LAS float* Ys = Xs + 64 * 64;
    LAS float* dd = Ys + 64 * 64;
    const int g = h >> 4, nl = tid & 15, pg = tid >> 4;
    const float a = -expf(a_log[h]), dsk = dskip[h];
    float s0[8], s1[8];
#pragma unroll
    for (int j = 0; j < 8; ++j) { s0[j] = 0.f; s1[j] = 0.f; }
    const size_t mbase = (size_t)b * T;
    v4u rB[2], rC[2], rX, rZ; float rdt = 0.f;
    const int brow = tid >> 4, bc8 = tid & 15, xrow = tid >> 3, xc8 = tid & 7;
#define SSD_LOAD(st) do { const size_t m0_ = mbase + (size_t)(st) * 64; \
        _Pragma("unroll") for (int i = 0; i < 2; ++i) { const bf16* p_ = XBC2 + (m0_ + brow + 32 * i) * S_CONV + 8192 + g * 128 + bc8 * 8; rB[i] = *(const v4u*)p_; rC[i] = *(const v4u*)(p_ + 1024); } \
        rX = *(const v4u*)(XBC2 + (m0_ + xrow) * S_CONV + h * 64 + xc8 * 8); rZ = *(const v4u*)(Z + (m0_ + xrow) * S_DI + h * 64 + xc8 * 8); \
        if (tid < 64) rdt = DTV[(m0_ + tid) * 128 + h]; } while (0)
    SSD_LOAD(0);
    for (int st = 0; st < T / 64; ++st) {
        __syncthreads();
#pragma unroll
        for (int i = 0; i < 2; ++i) { float f[8];
            bf8_to_f32(rB[i], f); *(LAS f32x4*)(Bs + (brow + 32 * i) * 128 + bc8 * 8) = (f32x4){f[0], f[1], f[2], f[3]}; *(LAS f32x4*)(Bs + (brow + 32 * i) * 128 + bc8 * 8 + 4) = (f32x4){f[4], f[5], f[6], f[7]};
            bf8_to_f32(rC[i], f); *(LAS f32x4*)(Cs + (brow + 32 * i) * 128 + bc8 * 8) = (f32x4){f[0], f[1], f[2], f[3]}; *(LAS f32x4*)(Cs + (brow + 32 * i) * 128 + bc8 * 8 + 4) = (f32x4){f[4], f[5], f[6], f[7]}; }
        { float f[8]; bf8_to_f32(rX, f); *(LAS f32x4*)(Xs + xrow * 64 + xc8 * 8) = (f32x4){f[0], f[1], f[2], f[3]}; *(LAS f32x4*)(Xs + xrow * 64 + xc8 * 8 + 4) = (f32x4){f[4], f[5], f[6], f[7]}; }
        if (tid < 64) { dd[2 * tid] = rdt; dd[2 * tid + 1] = expf(rdt * a); }
        const v4u zcur = rZ;
        const size_t m0 = mbase + (size_t)st * 64;
        __syncthreads();
        if (st + 1 < T / 64) SSD_LOAD(st + 1);
#pragma unroll 4
        for (int t = 0; t < 64; ++t) {
            const f32x2 dv = *(const LAS f32x2*)(dd + 2 * t); const f32x2 xv = *(const LAS f32x2*)(Xs + t * 64 + 2 * pg);
            const float da = dv.y, u0 = xv.x * dv.x, u1 = xv.y * dv.x;
            const f32x4 b0 = *(const LAS f32x4*)(Bs + t * 128 + 4 * nl), b1 = *(const LAS f32x4*)(Bs + t * 128 + 64 + 4 * nl);
            const f32x4 c0 = *(const LAS f32x4*)(Cs + t * 128 + 4 * nl), c1 = *(const LAS f32x4*)(Cs + t * 128 + 64 + 4 * nl);
            float y0 = 0.f, y1 = 0.f;
#pragma unroll
            for (int j = 0; j < 4; ++j) {
                s0[j] = s0[j] * da + u0 * b0[j]; y0 += s0[j] * c0[j]; s1[j] = s1[j] * da + u1 * b0[j]; y1 += s1[j] * c0[j];
                s0[4 + j] = s0[4 + j] * da + u0 * b1[j]; y0 += s0[4 + j] * c1[j]; s1[4 + j] = s1[4 + j] * da + u1 * b1[j]; y1 += s1[4 + j] * c1[j]; }
            y0 = red16(y0); y1 = red16(y1);
            if (nl == 0) *(LAS f32x2*)(Ys + t * 64 + 2 * pg) = (f32x2){y0, y1};
        }
        __syncthreads();
        { float z[8], o[8]; bf8_to_f32(zcur, z); float ssq = 0.f;
#pragma unroll
          for (int j = 0; j < 8; ++j) { const float y = Ys[xrow * 64 + xc8 * 8 + j] + dsk * Xs[xrow * 64 + xc8 * 8 + j]; const float yg = y * silu(z[j]); o[j] = yg; ssq += yg * yg; }
          v4u ov; ov.x = pk2(o[0], o[1]); ov.y = pk2(o[2], o[3]); ov.z = pk2(o[4], o[5]); ov.w = pk2(o[6], o[7]);
          *(v4u*)(YG + (m0 + xrow) * S_DI + h * 64 + xc8 * 8) = ov;
          ssq = red8(ssq); if (xc8 == 0) SSQ[(m0 + xrow) * 128 + h] = ssq; }
    }
#undef SSD_LOAD
}
__device__ __forceinline__ void ssd_norm_row(bf16* yrow, const float* ssqrow, const float* nw, int lane) {
    float v = ssqrow[lane], w = ssqrow[64 + lane]; v = red16(v); w = red16(w);
    float rs[8];
#pragma unroll
    for (int gq = 0; gq < 4; ++gq) { rs[gq] = 1.0f / sqrtf(__shfl(v, 16 * gq) * (1.f / 1024.f) + INNER_EPS); rs[4 + gq] = 1.0f / sqrtf(__shfl(w, 16 * gq) * (1.f / 1024.f) + INNER_EPS); }
#pragma unroll
    for (int j = 0; j < 16; ++j) { const int c = (j * 64 + lane) * 8; float f[8]; bf8_to_f32(*(const v4u*)(yrow + c), f);
        const f32x4 w0 = *(const f32x4*)(nw + c), w1 = *(const f32x4*)(nw + c + 4); const float r = rs[j >> 1];
        v4u ov; ov.x = pk2(f[0] * r * w0.x, f[1] * r * w0.y); ov.y = pk2(f[2] * r * w0.z, f[3] * r * w0.w); ov.z = pk2(f[4] * r * w1.x, f[5] * r * w1.y); ov.w = pk2(f[6] * r * w1.z, f[7] * r * w1.w);
        *(v4u*)(yrow + c) = ov; }
}
__device__ __forceinline__ void gla_decay_rows(const float* GKL, const float* gk_up, const float* gk_bias, float* E, int row0, int rstride, int tid) {
    f32x4 up[16];
#pragma unroll
    for (int r = 0; r < 16; ++r) up[r] = *(const f32x4*)(gk_up + (size_t)r * 2048 + tid * 4);
    const f32x4 bias = *(const f32x4*)(gk_bias + tid * 4);
    for (int m = row0; m < M; m += rstride) {
        const float* gl = GKL + (size_t)m * 16; f32x4 z = bias;
#pragma unroll
        for (int r = 0; r < 16; ++r) { const float gq = gl[r]; z = z + up[r] * gq; }
        f32x4 e;
#pragma unroll
        for (int j = 0; j < 4; ++j) { const float ls = fminf(z[j], 0.f) - log1pf(expf(-fabsf(z[j]))); e[j] = expf(ls * (1.f / 16.f)); }
        *(f32x4*)(E + (size_t)m * 2048 + tid * 4) = e;
    }
}
__device__ __forceinline__ void gla_scan_unit(LAS unsigned char* lds, int b, int h, int s, const bf16* PROJ, const float* E, bf16* O, float* SSQ2, int tid) {
    LAS float* Es = (LAS float*)lds;
    LAS float* Ks = Es + 32 * 256;
    LAS float* Qs = Ks + 32 * 256;
    LAS float* Vs = Qs + 32 * 256;
    LAS float* Os = Vs + 32 * 32;
    const int nl = tid & 31, pg = tid >> 5;
    float s0[8], s1[8];
#pragma unroll
    for (int j = 0; j < 8; ++j) { s0[j] = 0.f; s1[j] = 0.f; }
    const size_t mbase = (size_t)b * T;
    f32x4 rE[4]; v4u rK[2], rQ[2], rV = (v4u){0u, 0u, 0u, 0u};
    const int erow = tid >> 6, ec4 = tid & 63, krow = tid >> 5, kc8 = tid & 31, vrow = (tid >> 2) & 31, vc8 = tid & 3;
#define GLA_LOAD(st) do { const size_t m0_ = mbase + (size_t)(st) * 32; \
        _Pragma("unroll") for (int i = 0; i < 4; ++i) rE[i] = *(const f32x4*)(E + (m0_ + erow + 8 * i) * 2048 + h * 256 + ec4 * 4); \
        _Pragma("unroll") for (int i = 0; i < 2; ++i) { const bf16* p_ = PROJ + (m0_ + krow + 16 * i) * G_PROJ + h * 256 + kc8 * 8; rQ[i] = *(const v4u*)p_; rK[i] = *(const v4u*)(p_ + 2048); } \
        if (tid < 128) rV = *(const v4u*)(PROJ + (m0_ + vrow) * G_PROJ + 4096 + h * 512 + s * 32 + vc8 * 8); } while (0)
    GLA_LOAD(0);
    for (int st = 0; st < T / 32; ++st) {
        __syncthreads();
#pragma unroll
        for (int i = 0; i < 4; ++i) *(LAS f32x4*)(Es + (erow + 8 * i) * 256 + ec4 * 4) = rE[i];
#pragma unroll
        for (int i = 0; i < 2; ++i) { float f[8];
            bf8_to_f32(rK[i], f); *(LAS f32x4*)(Ks + (krow + 16 * i) * 256 + kc8 * 8) = (f32x4){f[0], f[1], f[2], f[3]}; *(LAS f32x4*)(Ks + (krow + 16 * i) * 256 + kc8 * 8 + 4) = (f32x4){f[4], f[5], f[6], f[7]};
            bf8_to_f32(rQ[i], f); *(LAS f32x4*)(Qs + (krow + 16 * i) * 256 + kc8 * 8) = (f32x4){f[0], f[1], f[2], f[3]} * 0.0625f; *(LAS f32x4*)(Qs + (krow + 16 * i) * 256 + kc8 * 8 + 4) = (f32x4){f[4], f[5], f[6], f[7]} * 0.0625f; }
        if (tid < 128) { float f[8]; bf8_to_f32(rV, f); *(LAS f32x4*)(Vs + vrow * 32 + vc8 * 8) = (f32x4){f[0], f[1], f[2], f[3]}; *(LAS f32x4*)(Vs + vrow * 32 + vc8 * 8 + 4) = (f32x4){f[4], f[5], f[6], f[7]}; }
        const size_t m0 = mbase + (size_t)st * 32;
        __syncthreads();
        if (st + 1 < T / 32) GLA_LOAD(st + 1);
#pragma unroll 4
        for (int t = 0; t < 32; ++t) {
            const f32x2 vv = *(const LAS f32x2*)(Vs + t * 32 + 2 * pg);
            const f32x4 e0 = *(const LAS f32x4*)(Es + t * 256 + 4 * nl), e1 = *(const LAS f32x4*)(Es + t * 256 + 128 + 4 * nl);
            const f32x4 k0 = *(const LAS f32x4*)(Ks + t * 256 + 4 * nl), k1 = *(const LAS f32x4*)(Ks + t * 256 + 128 + 4 * nl);
            const f32x4 q0 = *(const LAS f32x4*)(Qs + t * 256 + 4 * nl), q1 = *(const LAS f32x4*)(Qs + t * 256 + 128 + 4 * nl);
            float o0 = 0.f, o1 = 0.f;
#pragma unroll
            for (int j = 0; j < 4; ++j) {
                s0[j] = s0[j] * e0[j] + vv.x * k0[j]; o0 += s0[j] * q0[j]; s1[j] = s1[j] * e0[j] + vv.y * k0[j]; o1 += s1[j] * q0[j];
                s0[4 + j] = s0[4 + j] * e1[j] + vv.x * k1[j]; o0 += s0[4 + j] * q1[j]; s1[4 + j] = s1[4 + j] * e1[j] + vv.y * k1[j]; o1 += s1[4 + j] * q1[j]; }
            o0 = red32(o0); o1 = red32(o1);
            if (nl == 0) *(LAS f32x2*)(Os + t * 32 + 2 * pg) = (f32x2){o0, o1};
        }
        __syncthreads();
        if (tid < 128) { float o[8]; float ssq = 0.f;
#pragma unroll
            for (int j = 0; j < 8; ++j) { o[j] = Os[vrow * 32 + vc8 * 8 + j]; ssq += o[j] * o[j]; }
            v4u ov; ov.x = pk2(o[0], o[1]); ov.y = pk2(o[2], o[3]); ov.z = pk2(o[4], o[5]); ov.w = pk2(o[6], o[7]);
            *(v4u*)(O + (m0 + vrow) * D + h * 512 + s * 32 + vc8 * 8) = ov;
            ssq = red4(ssq); if (vc8 == 0) SSQ2[(m0 + vrow) * 128 + h * 16 + s] = ssq; }
    }
#undef GLA_LOAD
}
__device__ __forceinline__ void gla_norm_row(bf16* orow, const bf16* grow, const float* ssqrow, const float* nw, int lane) {
    float v = ssqrow[lane], w = ssqrow[64 + lane]; v = red16(v); w = red16(w);
    float rs[8];
#pragma unroll
    for (int gq = 0; gq < 4; ++gq) { rs[gq] = 1.0f / sqrtf(__shfl(v, 16 * gq) * (1.f / 512.f) + INNER_EPS); rs[4 + gq] = 1.0f / sqrtf(__shfl(w, 16 * gq) * (1.f / 512.f) + INNER_EPS); }
#pragma unroll
    for (int j = 0; j < 8; ++j) { const int c = (j * 64 + lane) * 8; float f[8], gt[8]; bf8_to_f32(*(const v4u*)(orow + c), f); bf8_to_f32(*(const v4u*)(grow + c), gt);
        const f32x4 w0 = *(const f32x4*)(nw + (c & 511)), w1 = *(const f32x4*)(nw + (c & 511) + 4); const float r = rs[j];
        v4u ov; ov.x = pk2(f[0] * r * w0.x * silu(gt[0]), f[1] * r * w0.y * silu(gt[1])); ov.y = pk2(f[2] * r * w0.z * silu(gt[2]), f[3] * r * w0.w * silu(gt[3]));
        ov.z = pk2(f[4] * r * w1.x * silu(gt[4]), f[5] * r * w1.y * silu(gt[5])); ov.w = pk2(f[6] * r * w1.z * silu(gt[6]), f[7] * r * w1.w * silu(gt[7]));
        *(v4u*)(orow + c) = ov; }
}

struct Args { const float* in[25]; float* out; unsigned char* ws; int ph_lo, ph_hi; };
__global__ void __launch_bounds__(NWAVES * 64, 2) trunk_fwd(Args args) {
    extern __shared__ __attribute__((aligned(16))) unsigned char lds_raw[];
    LAS unsigned char* lds = (LAS unsigned char*)lds_raw;
    volatile LAS unsigned* MISC = (volatile LAS unsigned*)(lds + MISC_OFF);
    const int tid = threadIdx.x, lane = tid & 63, wave = __builtin_amdgcn_readfirstlane(tid >> 6);
    const int G = gridDim.x, bx = blockIdx.x;
    const int vcu = (G % 8 == 0) ? (bx % 8) * (G / 8) + bx / 8 : bx;
    const int gw = vcu * NWAVES + wave, NGW = G * NWAVES;
    unsigned char* ws = args.ws;
    const int lo = args.ph_lo, hi = args.ph_hi;
    for (int u = tid; u < (LDS_BYTES - LDSCTL_OFF) / 4; u += NWAVES * 64) ((LAS unsigned*)(lds + LDSCTL_OFF))[u] = 0u;
    __syncthreads();
    XcdBarrier bar; bar.bar = (unsigned*)(ws + WS_CTL) + CW_BAR; bar.x = 0; bar.st = nullptr;
    if (hi - lo > 1) bar = xcd_barrier_post((unsigned*)(ws + WS_CTL) + CW_BAR, MISC + 8);
#define IN(k) (lo <= (k) && (k) < hi)
#define SEAM(k) do { if (IN(k) && IN((k) + 1)) xcd_barrier(bar); } while (0)
    const float* x = args.in[0];
    const float *l0_mixer_norm = args.in[1], *l0_in_proj = args.in[2], *l0_conv_w = args.in[3], *l0_conv_b = args.in[4], *l0_dt_bias = args.in[5], *l0_a_log = args.in[6], *l0_d = args.in[7],
                *l0_norm_w = args.in[8], *l0_out_proj = args.in[9], *l0_ffn_norm = args.in[10], *l0_w_gate = args.in[11], *l0_w_up = args.in[12], *l0_w_down = args.in[13];
    const float *l1_mixer_norm = args.in[14], *l1_in_proj = args.in[15], *l1_gk_up = args.in[16], *l1_gk_bias = args.in[17], *l1_norm_w = args.in[18], *l1_out_proj = args.in[19],
                *l1_ffn_norm = args.in[20], *l1_w_gate = args.in[21], *l1_w_up = args.in[22], *l1_w_down = args.in[23], *final_norm = args.in[24];
    float* out = args.out;
    bf16 *WIN = (bf16*)(ws + WS_WIN), *WOUT0 = (bf16*)(ws + WS_WOUT0), *WOUT1 = (bf16*)(ws + WS_WOUT1), *WGU = (bf16*)(ws + WS_WGU), *WDN = (bf16*)(ws + WS_WDN), *XN = (bf16*)(ws + WS_XN);
    bf16 *Zb = (bf16*)(ws + WS_Z), *XBC = (bf16*)(ws + WS_XBC), *XBC2 = (bf16*)(ws + WS_XBC2), *YG = (bf16*)(ws + WS_YG), *ACT = (bf16*)(ws + WS_ACT), *PROJ = (bf16*)(ws + WS_PROJ), *Ob = (bf16*)(ws + WS_O);
    float *DT = (float*)(ws + WS_DT), *SSQ = (float*)(ws + WS_SSQ), *GKL = (float*)(ws + WS_GKL), *Eb = (float*)(ws + WS_E), *SSQ2 = (float*)(ws + WS_SSQ2);
    LAS float* scr = (LAS float*)(lds + RING_OFF + wave * 16384);

    if (IN(0)) {
        const WJob j0{l0_in_proj, WIN, D, S_IN, 0}, j1{l0_out_proj, WOUT0, S_DI, D, 0}, j2{l0_w_gate, WGU, D, DFF, 1}, j3{l0_w_up, WGU, D, DFF, 2}, j4{l0_w_down, WDN, DFF, D, 0};
        convert_layer(j0, j1, j2, j3, j4, scr, gw, NGW, lane);
        zero_rows_bf16(WIN + (size_t)S_IN * D, (size_t)(S_INP - S_IN) * D, vcu * 512 + tid, G * 512);
        for (int m = gw; m < M; m += NGW) rmsnorm_row_bf16(x + (size_t)m * D, l0_mixer_norm, XN + (size_t)m * D, lane);
    }
    SEAM(0);
    if (IN(1)) {
        pg8::Gemm g{XN, WIN, M, S_INP, D}; pg8::StaticOrder S; S.init(M, S_INP, G, bx);
        pg8::EpiSsdIn E{Zb, XBC, DT};
        pg8::gemm_phase<pg8::EpiSsdIn, pg8::StaticOrder, true, true>(lds + RING_OFF, g, S, E);
    }
    SEAM(1);
    if (IN(2)) {
        for (int it = gw; it < (M / 64) * 20; it += NGW) conv_item(XBC, XBC2, l0_conv_w, l0_conv_b, it, lane);
        for (int i = vcu * 512 + tid; i < M * 128 / 4; i += G * 512) { f32x4 v = *(const f32x4*)(DT + (size_t)i * 4); const f32x4 bb = *(const f32x4*)(l0_dt_bias + ((i * 4) & 127));
            v = (f32x4){softplus(v.x + bb.x), softplus(v.y + bb.y), softplus(v.z + bb.z), softplus(v.w + bb.w)}; *(f32x4*)(DT + (size_t)i * 4) = v; }
    }
    SEAM(2);
    if (IN(3)) {
        for (int u = bx; u < 256; u += G) { const int xcd = u & 7, j = u >> 3, pair = xcd * 2 + (j >> 4), b = pair >> 3, gq = pair & 7, r = j & 15;
            ssd_scan_unit(lds + RING_OFF, b, gq * 16 + r, XBC2, Zb, DT, l0_a_log, l0_d, YG, SSQ, tid); __syncthreads(); }
    }
    SEAM(3);
    if (IN(4)) { for (int m = gw; m < M; m += NGW) ssd_norm_row(YG + (size_t)m * S_DI, SSQ + (size_t)m * 128, l0_norm_w, lane); }
    SEAM(4);
    if (IN(5)) {
        pg8::Gemm g{YG, WOUT0, M, D, S_DI}; pg8::StaticOrder S; S.init(M, D, G, bx);
        pg8::EpiResF32 E{x, out, D};
        pg8::gemm_phase<pg8::EpiResF32, pg8::StaticOrder, true, true>(lds + RING_OFF, g, S, E);
    }
    SEAM(5);
    if (IN(6)) { for (int m = gw; m < M; m += NGW) rmsnorm_row_bf16(out + (size_t)m * D, l0_ffn_norm, XN + (size_t)m * D, lane); }
    SEAM(6);
    if (IN(7)) {
        pg8::Gemm g{XN, WGU, M, GU_N, D}; pg8::StaticOrder S; S.init(M, GU_N, G, bx);
        pg8::EpiSwiGLU E{ACT, DFF};
        pg8::gemm_phase<pg8::EpiSwiGLU, pg8::StaticOrder, true, true>(lds + RING_OFF, g, S, E);
    }
    SEAM(7);
    if (IN(8)) {
        pg8::Gemm g{ACT, WDN, M, D, DFF}; pg8::StaticOrder S; S.init(M, D, G, bx);
        pg8::EpiResF32 E{out, out, D};
        pg8::gemm_phase<pg8::EpiResF32, pg8::StaticOrder, true, true>(lds + RING_OFF, g, S, E);
    }
    SEAM(8);
    if (IN(9)) {
        const WJob j0{l1_in_proj, WIN, D, G_IN, 0}, j1{l1_out_proj, WOUT1, D, D, 0}, j2{l1_w_gate, WGU, D, DFF, 1}, j3{l1_w_up, WGU, D, DFF, 2}, j4{l1_w_down, WDN, DFF, D, 0};
        convert_layer(j0, j1, j2, j3, j4, scr, gw, NGW, lane);
        zero_rows_bf16(WIN + (size_t)G_IN * D, (size_t)(G_INP - G_IN) * D, vcu * 512 + tid, G * 512);
        for (int m = gw; m < M; m += NGW) rmsnorm_row_bf16(out + (size_t)m * D, l1_mixer_norm, XN + (size_t)m * D, lane);
    }
    SEAM(9);
    if (IN(10)) {
        pg8::Gemm g{XN, WIN, M, G_INP, D}; pg8::StaticOrder S; S.init(M, G_INP, G, bx);
        pg8::EpiGlaIn E{PROJ, GKL};
        pg8::gemm_phase<pg8::EpiGlaIn, pg8::StaticOrder, true, true>(lds + RING_OFF, g, S, E);
    }
    SEAM(10);
    if (IN(11)) gla_decay_rows(GKL, l1_gk_up, l1_gk_bias, Eb, vcu, G, tid);
    SEAM(11);
    if (IN(12)) {
        for (int u = bx; u < 256; u += G) { const int xcd = u & 7, j = u >> 3, pair = xcd * 2 + (j >> 4), b = pair >> 3, hh = pair & 7, sl = j & 15;
            gla_scan_unit(lds + RING_OFF, b, hh, sl, PROJ, Eb, Ob, SSQ2, tid); __syncthreads(); }
    }
    SEAM(12);
    if (IN(13)) { for (int m = gw; m < M; m += NGW) gla_norm_row(Ob + (size_t)m * D, PROJ + (size_t)m * G_PROJ + 8192, SSQ2 + (size_t)m * 128, l1_norm_w, lane); }
    SEAM(13);
    if (IN(14)) {
        pg8::Gemm g{Ob, WOUT1, M, D, D}; pg8::StaticOrder S; S.init(M, D, G, bx);
        pg8::EpiResF32 E{out, out, D};
        pg8::gemm_phase<pg8::EpiResF32, pg8::StaticOrder, true, true>(lds + RING_OFF, g, S, E);
    }
    SEAM(14);
    if (IN(15)) { for (int m = gw; m < M; m += NGW) rmsnorm_row_bf16(out + (size_t)m * D, l1_ffn_norm, XN + (size_t)m * D, lane); }
    SEAM(15);
    if (IN(16)) {
        pg8::Gemm g{XN, WGU, M, GU_N, D}; pg8::StaticOrder S; S.init(M, GU_N, G, bx);
        pg8::EpiSwiGLU E{ACT, DFF};
        pg8::gemm_phase<pg8::EpiSwiGLU, pg8::StaticOrder, true, true>(lds + RING_OFF, g, S, E);
    }
    SEAM(16);
    if (IN(17)) {
        pg8::Gemm g{ACT, WDN, M, D, DFF}; pg8::StaticOrder S; S.init(M, D, G, bx);
        pg8::EpiResF32 E{out, out, D};
        pg8::gemm_phase<pg8::EpiResF32, pg8::StaticOrder, true, true>(lds + RING_OFF, g, S, E);
    }
    SEAM(17);
    if (IN(18)) { for (int m = gw; m < M; m += NGW) rmsnorm_row_f32(out + (size_t)m * D, final_norm, lane); }
#undef IN
#undef SEAM
}

extern "C" void kernel_launch(void* const* d_in, const int* in_sizes, int n_in, void* d_out, int out_size, void* d_ws, size_t ws_size, hipStream_t stream) {
    static int grid = 0;
    if (grid == 0) {
        if (n_in != 25 || in_sizes[0] != M * D || out_size != M * D || ws_size < WS_END) { fprintf(stderr, "kernel_launch: unexpected problem (n_in %d, in0 %d, out %d, ws %zu < %zu); nothing launched\n", n_in, n_in > 0 ? in_sizes[0] : -1, out_size, ws_size, (size_t)WS_END); grid = -1; return; }
        int dev = 0, cus = 0, per_cu = 0;
        if (hipGetDevice(&dev) != hipSuccess || hipDeviceGetAttribute(&cus, hipDeviceAttributeMultiprocessorCount, dev) != hipSuccess) { fprintf(stderr, "kernel_launch: device query failed\n"); grid = -1; return; }
        if (hipFuncSetAttribute((const void*)trunk_fwd, hipFuncAttributeMaxDynamicSharedMemorySize, LDS_BYTES) != hipSuccess) { fprintf(stderr, "kernel_launch: hipFuncSetAttribute failed\n"); grid = -1; return; }
        if (hipOccupancyMaxActiveBlocksPerMultiprocessor(&per_cu, (const void*)trunk_fwd, NWAVES * 64, LDS_BYTES) != hipSuccess || per_cu < 1)
            fprintf(stderr, "kernel_launch: note: occupancy query reports %d workgroups per CU\n", per_cu);
        (void)hipGetLastError();
        grid = cus;
    }
    if (grid < 0) return;
    if (hipMemsetAsync((char*)d_ws + WS_CTL, 0, CTL_ZERO_BYTES, stream) != hipSuccess) { fprintf(stderr, "kernel_launch: memset failed\n"); return; }
    Args a{};
    for (int i = 0; i < 25; ++i) a.in[i] = (const float*)d_in[i];
    a.out = (float*)d_out; a.ws = (unsigned char*)d_ws;
#if MK_SPLIT
    for (int p = 0; p < NPHASE; ++p) { a.ph_lo = p; a.ph_hi = p + 1; hipLaunchKernelGGL(trunk_fwd, dim3(grid), dim3(NWAVES * 64), LDS_BYTES, stream, a); }
#else
    a.ph_lo = 0; a.ph_hi = NPHASE;
    hipLaunchKernelGGL(trunk_fwd, dim3(grid), dim3(NWAVES * 64), LDS_BYTES, stream, a);
#endif
    const hipError_t le = hipPeekAtLastError();
    if (le != hipSuccess) fprintf(stderr, "kernel_launch: launch failed: %s\n", hipGetErrorName(le));
}
```

```cpp
#include <hip/hip_runtime.h>
#include <cstdio>
#include <cstdint>
namespace pg8 {
#define PG8_LAS __attribute__((address_space(3)))
typedef unsigned short bf16_t;
typedef short bf16x8 __attribute__((ext_vector_type(8)));
typedef float f32x4 __attribute__((ext_vector_type(4)));
typedef unsigned u32x4 __attribute__((ext_vector_type(4)));
constexpr int BM = 256, BK = 64, HALF = 128, HTB = HALF * BK * 2  , STAGE_BYTES = 8 * HTB, NXCD = 8, WGM = 8;

__host__ __device__ __forceinline__ int lds_byte(int r, int c) { const int st = (r >> 4) * 2 + (c >> 5), rr = r & 15, cc = c & 31, ob = rr * 64 + cc * 2; return st * 1024 + (ob ^ (((ob >> 9) & 1) << 5)); }
__host__ __device__ __forceinline__ void stage_rc(int b, int& R, int& C) { const int st = b / 1024, sb = b % 1024, swz = sb ^ (((sb >> 9) & 1) << 5); R = (st >> 1) * 16 + swz / 64; C = (st & 1) * 32 + (swz % 64) / 2; }
__host__ __device__ __forceinline__ int perm32(int rho) { const int n = rho >> 4, i = rho & 15; return 8 * (i >> 2) + 4 * n + (i & 3); }

struct Unit { int pm, pn, g; };
struct Gemm { const bf16_t* A; const bf16_t* Bt; int M, N, K, lda, ldb; };

struct StaticOrder {
    int nM, nN, nwg, G, c;
    __host__ __device__ void init(int M, int N, int G_, int c_) { nM = M / BM; nN = N / BM; nwg = nM * nN; G = G_; c = c_; }
    __host__ __device__ bool next(int i, Unit& u) const {
        const long L = (long)i * G + c; if (L >= nwg) return false;
        int wgid = (int)L; { const int q = nwg / NXCD, r = nwg % NXCD, xcd = wgid % NXCD, off = wgid / NXCD; wgid = (xcd < r ? xcd * (q + 1) : r * (q + 1) + (xcd - r) * q) + off; }
        const int nig = WGM * nN, gid = wgid / nig, fm = gid * WGM, gsz = (nM - fm) < WGM ? (nM - fm) : WGM;
        u.pm = fm + ((wgid % nig) % gsz); u.pn = (wgid % nig) / gsz; u.g = 0; return true;
    }
    __device__ __forceinline__ size_t aoff(const Unit& u, int lda) const { return (size_t)u.pm * BM * lda * 2; }
    __device__ __forceinline__ size_t boff(const Unit& u, int ldb) const { return (size_t)u.pn * BM * ldb * 2; }
    __device__ __forceinline__ void a_ready(const Unit&) const {}
    __device__ __forceinline__ void done(const Unit&) const {}
};
struct GroupedOrder {
    StaticOrder base; int kg;
    __host__ __device__ void init(int M, int N, int G_, int c_, int kg_) { base.init(M, N, G_, c_); kg = kg_; }
    __host__ __device__ bool next(int j, Unit& u) const { if (!base.next(j >> 3, u)) return false; u.g = j & 7; return true; }
    __host__ __device__ bool tile_next(int i, Unit& u) const { return base.next(i, u); }
    __device__ __forceinline__ size_t aoff(const Unit& u, int lda) const { return ((size_t)u.pm * BM * lda + (size_t)u.g * kg) * 2; }
    __device__ __forceinline__ size_t boff(const Unit& u, int ldb) const { return ((size_t)u.pn * BM * ldb + (size_t)u.g * kg) * 2; }
    __device__ __forceinline__ void a_ready(const Unit&) const {}
    __device__ __forceinline__ void done(const Unit&) const {}
};
struct KSplitOrder {
    int nM, G, c, pn0, kslice;
    __host__ __device__ void init(int M, int G_, int c_, int pn0_, int kslice_) { nM = M / BM; G = G_; c = c_; pn0 = pn0_; kslice = kslice_; }
    __host__ __device__ bool next(int i, Unit& u) const { const long L = (long)i * G + c; if (L >= (long)nM * 4) return false; u.pm = (int)(L >> 2); u.pn = (int)(L & 3); u.g = 0; return true; }
    __device__ __forceinline__ size_t aoff(const Unit& u, int lda) const { return ((size_t)u.pm * BM * lda + (size_t)u.pn * kslice) * 2; }
    __device__ __forceinline__ size_t boff(const Unit& u, int ldb) const { return ((size_t)pn0 * BM * ldb + (size_t)u.pn * kslice) * 2; }
    __device__ __forceinline__ void a_ready(const Unit&) const {}
    __device__ __forceinline__ void done(const Unit&) const {}
};
__device__ __forceinline__ unsigned cvt_pk_bf16(float lo, float hi) { unsigned r; asm volatile("v_cvt_pk_bf16_f32 %0, %1, %2" : "=v"(r) : "v"(lo), "v"(hi)); return r; }
typedef float f32x2 __attribute__((ext_vector_type(2)));
__device__ __forceinline__ float silu_f(float v) { return v * __builtin_amdgcn_rcpf(1.0f + __builtin_amdgcn_exp2f(-1.44269504f * v)); }
__device__ __forceinline__ u32x4 pack8(const f32x4 v0, const f32x4 v1) { u32x4 w; w.x = cvt_pk_bf16(v0[0], v0[1]); w.y = cvt_pk_bf16(v0[2], v0[3]); w.z = cvt_pk_bf16(v1[0], v1[1]); w.w = cvt_pk_bf16(v1[2], v1[3]); return w; }

constexpr int ROWTAB_OFF = STAGE_BYTES + 1024;
__device__ __forceinline__ void rowtab_build(const float* psq, int pm, PG8_LAS unsigned char* lds, int tid) {
    const int row = tid >> 1; const float* p = psq + ((size_t)pm * BM + row) * 64 + (tid & 1) * 32; float sacc = 0.f;
#pragma unroll
    for (int i = 0; i < 8; ++i) { const f32x4 v = *(const f32x4*)(p + 4 * i); sacc += (v[0] + v[1]) + (v[2] + v[3]); }
    sacc += __shfl_xor(sacc, 1);
    if ((tid & 1) == 0) *(PG8_LAS float*)(lds + ROWTAB_OFF + row * 4) = 1.0f / sqrtf(sacc * (1.0f / 4096.0f) + 1e-6f);
}
__device__ __forceinline__ void rowtab_copy(const float* rstd, int pm, PG8_LAS unsigned char* lds, int tid) {
    if (tid < BM) *(PG8_LAS float*)(lds + ROWTAB_OFF + tid * 4) = rstd[(size_t)pm * BM + tid];
}
struct EpiSsdIn {
    static constexpr bool PERM = true, AFTER_DRAIN = false, GROUPED = false, ROWTAB = true;
    bf16_t* Z; bf16_t* XBC; const float* rstd;
    __device__ __forceinline__ void row_table(int pm, PG8_LAS unsigned char* lds, int tid) const { rowtab_copy(rstd, pm, lds, tid); }
    __device__ __forceinline__ void epi(const f32x4 (&acc)[2][2][4][2], const Unit& u, PG8_LAS unsigned char* lds, int wr, int wc, int fr, int fq) const {
        const PG8_LAS float* tab = (const PG8_LAS float*)(lds + ROWTAB_OFF) + wr * 64 + fr;
        const int row0 = u.pm * BM + wr * 64 + fr;
        bf16_t* base; int ldc, colt;
        if (u.pn < 32) { base = Z; ldc = 8192; colt = u.pn * BM; } else { base = XBC; ldc = 10240; colt = (u.pn - 32) * BM; }
        const int col0 = colt + wc * 32 + 8 * fq;
        float rs[2][4];
#pragma unroll
        for (int ai = 0; ai < 2; ++ai)
#pragma unroll
            for (int m = 0; m < 4; ++m) rs[ai][m] = tab[ai * HALF + m * 16];
#pragma unroll
        for (int ai = 0; ai < 2; ++ai)
#pragma unroll
            for (int m = 0; m < 4; ++m) { bf16_t* rowp = base + (size_t)(row0 + ai * HALF + m * 16) * ldc + col0; const float r = rs[ai][m];
#pragma unroll
                for (int bj = 0; bj < 2; ++bj) *(u32x4*)(rowp + bj * HALF) = pack8(acc[ai][bj][m][0] * r, acc[ai][bj][m][1] * r); }
    }
};
struct EpiDtPart {
    static constexpr bool PERM = true, AFTER_DRAIN = false, GROUPED = false, ROWTAB = true;
    float* DTP; const float* rstd;
    __device__ __forceinline__ void row_table(int pm, PG8_LAS unsigned char* lds, int tid) const { rowtab_copy(rstd, pm, lds, tid); }
    __device__ __forceinline__ void epi(const f32x4 (&acc)[2][2][4][2], const Unit& u, PG8_LAS unsigned char* lds, int wr, int wc, int fr, int fq) const {
        const PG8_LAS float* tab = (const PG8_LAS float*)(lds + ROWTAB_OFF) + wr * 64 + fr;
        const int row0 = u.pm * BM + wr * 64 + fr, col0 = wc * 32 + 8 * fq; float* base = DTP + (size_t)u.pn * 16384 * 128;
        float rs[2][4];
#pragma unroll
        for (int ai = 0; ai < 2; ++ai)
#pragma unroll
            for (int m = 0; m < 4; ++m) rs[ai][m] = tab[ai * HALF + m * 16];
#pragma unroll
        for (int ai = 0; ai < 2; ++ai)
#pragma unroll
            for (int m = 0; m < 4; ++m) { float* rowp = base + (size_t)(row0 + ai * HALF + m * 16) * 128 + col0; const float r = rs[ai][m];
                *(f32x4*)rowp = acc[ai][0][m][0] * r; *(f32x4*)(rowp + 4) = acc[ai][0][m][1] * r; }
    }
};
struct EpiGlaIn {
    static constexpr bool PERM = true, AFTER_DRAIN = false, GROUPED = false, ROWTAB = true;
    bf16_t* PROJ; const float* psq;
    __device__ __forceinline__ void row_table(int pm, PG8_LAS unsigned char* lds, int tid) const { rowtab_build(psq, pm, lds, tid); }
    __device__ __forceinline__ void epi(const f32x4 (&acc)[2][2][4][2], const Unit& u, PG8_LAS unsigned char* lds, int wr, int wc, int fr, int fq) const {
        const PG8_LAS float* tab = (const PG8_LAS float*)(lds + ROWTAB_OFF) + wr * 64 + fr;
        const int row0 = u.pm * BM + wr * 64 + fr, col0 = u.pn * BM + wc * 32 + 8 * fq;
#pragma unroll
        for (int ai = 0; ai < 2; ++ai)
#pragma unroll
            for (int m = 0; m < 4; ++m) { const int row = row0 + ai * HALF + m * 16; const float r = tab[ai * HALF + m * 16]; bf16_t* rowp = PROJ + (size_t)row * 12288 + col0;
#pragma unroll
                for (int bj = 0; bj < 2; ++bj) *(u32x4*)(rowp + bj * HALF) = pack8(acc[ai][bj][m][0] * r, acc[ai][bj][m][1] * r); }
    }
};
struct EpiGkPart {
    static constexpr bool PERM = true, AFTER_DRAIN = false, GROUPED = false, ROWTAB = true;
    float* GKP; const float* psq;
    __device__ __forceinline__ void row_table(int pm, PG8_LAS unsigned char* lds, int tid) const { rowtab_build(psq, pm, lds, tid); }
    __device__ __forceinline__ void epi(const f32x4 (&acc)[2][2][4][2], const Unit& u, PG8_LAS unsigned char* lds, int wr, int wc, int fr, int fq) const {
        const PG8_LAS float* tab = (const PG8_LAS float*)(lds + ROWTAB_OFF) + wr * 64 + fr;
        const int row0 = u.pm * BM + wr * 64 + fr; float* base = GKP + (size_t)u.pn * 16384 * 16;
        if (wc == 0 && fq < 2) {
#pragma unroll
            for (int ai = 0; ai < 2; ++ai)
#pragma unroll
                for (int m = 0; m < 4; ++m) { const int row = row0 + ai * HALF + m * 16; const float r = tab[ai * HALF + m * 16]; float* rowp = base + (size_t)row * 16 + 8 * fq;
                    *(f32x4*)rowp = acc[ai][0][m][0] * r; *(f32x4*)(rowp + 4) = acc[ai][0][m][1] * r; }
        }
    }
};
struct EpiSwiGLU {
    static constexpr bool PERM = true, AFTER_DRAIN = false, GROUPED = false, ROWTAB = true;
    static constexpr int TAB_OFF = ROWTAB_OFF;
    bf16_t* O; int ldc; const float* psq;
    __device__ __forceinline__ void row_table(int pm, PG8_LAS unsigned char* lds, int tid) const { rowtab_build(psq, pm, lds, tid); }
    __device__ __forceinline__ void epi(const f32x4 (&acc)[2][2][4][2], const Unit& u, PG8_LAS unsigned char* lds, int wr, int wc, int fr, int fq) const {
        const PG8_LAS float* tab = (const PG8_LAS float*)(lds + TAB_OFF) + wr * 64 + fr;
        (*this)(acc, u, tab, wr, wc, fr, fq); }
    __device__ __forceinline__ void operator()(const f32x4 (&acc)[2][2][4][2], const Unit& u, const PG8_LAS float* tab, int wr, int wc, int fr, int fq) const {
        const int row0 = u.pm * BM + wr * 64 + fr, col0 = u.pn * HALF + wc * 32 + 8 * fq;
#pragma unroll
        for (int ai = 0; ai < 2; ++ai)
#pragma unroll
            for (int m = 0; m < 4; ++m) { const int row = row0 + ai * HALF + m * 16; const float r = tab[ai * HALF + m * 16]; bf16_t* rowp = O + (size_t)row * ldc + col0;
                const float c1 = -1.44269504f * r, r2 = r * r; const f32x2 c1v = {c1, c1}, r2v = {r2, r2}, one = {1.0f, 1.0f};
                f32x4 v[2];
#pragma unroll
                for (int n = 0; n < 2; ++n)
#pragma unroll
                    for (int h = 0; h < 2; ++h) { const f32x2 g = {acc[ai][0][m][n][2 * h], acc[ai][0][m][n][2 * h + 1]}, uu = {acc[ai][1][m][n][2 * h], acc[ai][1][m][n][2 * h + 1]};
                        const f32x2 t = g * c1v; const f32x2 d = (f32x2){__builtin_amdgcn_exp2f(t.x), __builtin_amdgcn_exp2f(t.y)} + one;
                        const f32x2 q = {__builtin_amdgcn_rcpf(d.x), __builtin_amdgcn_rcpf(d.y)};
                        const f32x2 o = ((g * uu) * r2v) * q; v[n][2 * h] = o.x; v[n][2 * h + 1] = o.y; }
                *(u32x4*)rowp = pack8(v[0], v[1]); }
    }
};
template <bool BASE_F32, bool GROUPED_> struct EpiResBf16 {
    static constexpr bool PERM = true, AFTER_DRAIN = false, GROUPED = GROUPED_, ROWTAB = false;
    const void* base; bf16_t* out; float* psq; const float* rat;
    static constexpr int TAB_OFF = STAGE_BYTES + 1024;
    __device__ __forceinline__ void tile_begin(const Unit& u, PG8_LAS unsigned char* lds, int par, int tid) const {
        int t_ = tid; asm volatile("" : "+v"(t_));
        *(PG8_LAS f32x4*)(lds + TAB_OFF + par * 8192 + t_ * 16) = *(const f32x4*)(rat + (size_t)u.pm * BM * 8 + t_ * 4);
    }
    __device__ __forceinline__ void rescale(f32x4 (&acc)[2][2][4][2], PG8_LAS unsigned char* lds, int par, int g, int wr, int fr) const {
        int rb = wr * 64 + fr; asm volatile("" : "+v"(rb));
        const PG8_LAS float* q = (const PG8_LAS float*)(lds + TAB_OFF + par * 8192) + rb * 8 + g;
#pragma unroll
        for (int ai = 0; ai < 2; ++ai)
#pragma unroll
            for (int m = 0; m < 4; ++m) { const float f = (g == 7) ? 0.f : q[(ai * HALF + m * 16) * 8];
#pragma unroll
                for (int bj = 0; bj < 2; ++bj)
#pragma unroll
                    for (int n = 0; n < 2; ++n) acc[ai][bj][m][n] = acc[ai][bj][m][n] * f; }
    }
    __device__ __forceinline__ void operator()(const f32x4 (&acc)[2][2][4][2], const Unit& u, int wr, int wc, int fr, int fq) const {
        const int row0 = u.pm * BM + wr * 64 + fr, col0 = u.pn * BM + wc * 32 + 8 * fq;
        constexpr int NB = BASE_F32 ? 2 : 4;
#pragma unroll
        for (int ai = 0; ai < 2; ++ai)
#pragma unroll
            for (int mb = 0; mb < 4; mb += NB) {
                f32x4 bf[NB][2][2]; u32x4 bw[NB][2]; float sc[NB];
#pragma unroll
                for (int i = 0; i < NB; ++i) { const int row = row0 + ai * HALF + (mb + i) * 16; const size_t off = (size_t)row * 4096 + col0;
                    sc[i] = GROUPED ? rat[(size_t)row * 8 + 7] : 1.0f;
#pragma unroll
                    for (int bj = 0; bj < 2; ++bj) {
                        if (BASE_F32) { bf[i][bj][0] = *(const f32x4*)((const float*)base + off + bj * HALF); bf[i][bj][1] = *(const f32x4*)((const float*)base + off + bj * HALF + 4); }
                        else bw[i][bj] = *(const u32x4*)((const bf16_t*)base + off + bj * HALF); } }
                if (GROUPED) asm volatile("" ::: "memory");
#pragma unroll
                for (int i = 0; i < NB; ++i) { const int m = mb + i; const int row = row0 + ai * HALF + m * 16; const size_t off = (size_t)row * 4096 + col0; f32x2 ssq2 = {0.f, 0.f};
#pragma unroll
                    for (int bj = 0; bj < 2; ++bj) { f32x4 b0, b1;
                        if (BASE_F32) { b0 = bf[i][bj][0]; b1 = bf[i][bj][1]; }
                        else { const u32x4 w = bw[i][bj];
                            b0 = (f32x4){__builtin_bit_cast(float, w.x << 16), __builtin_bit_cast(float, w.x & 0xffff0000u), __builtin_bit_cast(float, w.y << 16), __builtin_bit_cast(float, w.y & 0xffff0000u)};
                            b1 = (f32x4){__builtin_bit_cast(float, w.z << 16), __builtin_bit_cast(float, w.z & 0xffff0000u), __builtin_bit_cast(float, w.w << 16), __builtin_bit_cast(float, w.w & 0xffff0000u)}; }
                        const f32x4 v0 = GROUPED ? b0 + acc[ai][bj][m][0] * sc[i] : b0 + acc[ai][bj][m][0], v1 = GROUPED ? b1 + acc[ai][bj][m][1] * sc[i] : b1 + acc[ai][bj][m][1];
                        { const f32x2 p0 = {v0[0], v0[1]}, p1 = {v0[2], v0[3]}, p2 = {v1[0], v1[1]}, p3 = {v1[2], v1[3]}; ssq2 = ssq2 + p0 * p0; ssq2 = ssq2 + p1 * p1; ssq2 = ssq2 + p2 * p2; ssq2 = ssq2 + p3 * p3; }
                        *(u32x4*)(out + off + bj * HALF) = pack8(v0, v1); }
                    float ssq_ = ssq2.x + ssq2.y; ssq_ += __shfl_xor(ssq_, 16); ssq_ += __shfl_xor(ssq_, 32);
                    if (fq == 0) psq[(size_t)row * 64 + u.pn * 4 + wc] = ssq_; }
                if (GROUPED) asm volatile("" ::: "memory"); }
    }
};
template <class Epi, class Sched, bool ALIGN_EPI = false, bool SP2 = false>
__device__ __forceinline__ void gemm_phase(PG8_LAS unsigned char* lds, const Gemm g, const Sched& S, const Epi& E) {
    const int tid = threadIdx.x, wid = __builtin_amdgcn_readfirstlane(tid >> 6), lane = tid & 63, wr = wid >> 2, wc = wid & 3, fr = lane & 15, fq = lane >> 4;
    const int K = g.K, nt = K / BK, lda = g.lda, ldb = g.ldb;
    unsigned voffA[2], voffB[2];
#pragma unroll
    for (int i = 0; i < 2; ++i) { int R, C; stage_rc(tid * 16 + i * 8192, R, C); const int Rb = Epi::PERM ? ((R & ~31) + perm32(R & 31)) : R;
        voffA[i] = (unsigned)(R * lda + C) * 2u; voffB[i] = (unsigned)(Rb * ldb + C) * 2u; }
    const size_t kstep = (size_t)(BK * 2);
    const size_t hstepA = (size_t)HALF * lda * 2, hstepB = (size_t)HALF * ldb * 2;
    const unsigned ldsw = (unsigned)wid * 1024u;
    const int aoff = lds_byte(wr * 64 + fr, fq * 8), boff = lds_byte(wc * 32 + fr, fq * 8);
#define PG8_SA(b, h) (((b) * 2 + (h)) * HTB)
#define PG8_SB(b, h) ((4 + (b) * 2 + (h)) * HTB)
#define PG8_STAGE(bufoff, gbase, voff) do { _Pragma("unroll") for (int _i = 0; _i < 2; ++_i) \
        __builtin_amdgcn_global_load_lds((const unsigned*)((const char*)(gbase) + (voff)[_i]), (PG8_LAS unsigned*)(lds + (bufoff) + ldsw + _i * 8192), 16, 0, 0); } while (0)
#define PG8_LDA(dst, b, h) do { _Pragma("unroll") for (int m = 0; m < 4; ++m) _Pragma("unroll") for (int k = 0; k < 2; ++k) dst[m][k] = *(const PG8_LAS bf16x8*)(lds + PG8_SA(b, h) + aoff + m * 2048 + k * 1024); } while (0)
#define PG8_LDB(dst, b, h) do { _Pragma("unroll") for (int n = 0; n < 2; ++n) _Pragma("unroll") for (int k = 0; k < 2; ++k) dst[n][k] = *(const PG8_LAS bf16x8*)(lds + PG8_SB(b, h) + boff + n * 2048 + k * 1024); } while (0)
#ifndef PG8_PRIO_MODE
#define PG8_PRIO_MODE 1
#endif
#if PG8_PRIO_MODE == 1
#define PG8_PRIO_ON __builtin_amdgcn_s_setprio(1)
#define PG8_PRIO_OFF __builtin_amdgcn_s_setprio(0)
#else
#define PG8_PRIO_ON
#define PG8_PRIO_OFF
#endif
#define PG8_MMA(ai, bj, At, Bt) do { PG8_PRIO_ON; _Pragma("unroll") for (int m = 0; m < 4; ++m) _Pragma("unroll") for (int n = 0; n < 2; ++n) _Pragma("unroll") for (int k = 0; k < 2; ++k) \
        acc[ai][bj][m][n] = __builtin_amdgcn_mfma_f32_16x16x32_bf16(Bt[n][k], At[m][k], acc[ai][bj][m][n], 0, 0, 0); PG8_PRIO_OFF; } while (0)
#define PG8_WAIT_V(n) asm volatile("s_waitcnt vmcnt(" #n ")" ::: "memory")
#define PG8_WAIT_L(n) asm volatile("s_waitcnt lgkmcnt(" #n ")" ::: "memory")
#define PG8_BAR __builtin_amdgcn_s_barrier()
#define PG8_SCHED __builtin_amdgcn_sched_barrier(0)
    Unit cur, nxt, tnext; int ui = 0; bool tnext_ok = false; tnext.pm = 0; tnext.pn = 0; tnext.g = 0;
    if (!S.next(0, cur)) return;
    f32x4 acc[2][2][4][2];
#pragma unroll
    for (int a = 0; a < 2; ++a)
#pragma unroll
        for (int b = 0; b < 2; ++b)
#pragma unroll
            for (int m = 0; m < 4; ++m)
#pragma unroll
                for (int n = 0; n < 2; ++n) acc[a][b][m][n] = (f32x4){0.f, 0.f, 0.f, 0.f};
    bf16x8 At[4][2], B0[2][2], B1[2][2];
    const char* cA = (const char*)g.A + S.aoff(cur, lda); const char* cB = (const char*)g.Bt + S.boff(cur, ldb);
    S.a_ready(cur);
    if constexpr (Epi::GROUPED) E.tile_begin(cur, lds, 0, tid);
    if constexpr (SP2) {
        PG8_STAGE(PG8_SB(0, 0), cB, voffB); PG8_STAGE(PG8_SB(0, 1), cB + hstepB, voffB); PG8_STAGE(PG8_SA(0, 0), cA, voffA); PG8_STAGE(PG8_SA(0, 1), cA + hstepA, voffA);
        if (wr == 1) PG8_BAR;
        PG8_WAIT_V(2); PG8_BAR;
        PG8_STAGE(PG8_SB(1, 0), cB + kstep, voffB); PG8_STAGE(PG8_SA(1, 0), cA + kstep, voffA); PG8_STAGE(PG8_SB(1, 1), cB + hstepB + kstep, voffB);
        PG8_WAIT_V(6); PG8_BAR;
    } else {
        PG8_STAGE(PG8_SB(0, 0), cB, voffB); PG8_STAGE(PG8_SA(0, 0), cA, voffA); PG8_STAGE(PG8_SB(0, 1), cB + hstepB, voffB); PG8_STAGE(PG8_SA(0, 1), cA + hstepA, voffA);
        if (wr == 1) PG8_BAR;
        PG8_WAIT_V(4); PG8_BAR;
        PG8_STAGE(PG8_SB(1, 0), cB + kstep, voffB); PG8_STAGE(PG8_SA(1, 0), cA + kstep, voffA); PG8_STAGE(PG8_SB(1, 1), cB + hstepB + kstep, voffB);
        PG8_WAIT_V(6); PG8_BAR;
    }
    if constexpr (Epi::ROWTAB) E.row_table(cur.pm, lds, tid);
    for (;;) {
        bool has_next;
        if constexpr (Epi::GROUPED) {
            if (cur.g == 0) tnext_ok = S.tile_next((ui >> 3) + 1, tnext);
            if (cur.g < 7) { nxt = cur; nxt.g = cur.g + 1; has_next = true; } else { nxt = tnext; has_next = tnext_ok; }
        } else has_next = S.next(ui + 1, nxt);
        const char* nA = has_next ? (const char*)g.A + S.aoff(nxt, lda) : cA; const char* nB = has_next ? (const char*)g.Bt + S.boff(nxt, ldb) : cB;
        for (int t = 0; t < nt; t += 2) {
            const bool last = (t == nt - 2);
            const char* a1 = cA + (size_t)(t + 1) * kstep;
            const char* a2 = last ? nA : cA + (size_t)(t + 2) * kstep; const char* b2 = last ? nB : cB + (size_t)(t + 2) * kstep;
            const char* a3 = a2 + kstep; const char* b3 = b2 + kstep;
            if (last && has_next) S.a_ready(nxt);
            if constexpr (SP2) {
            PG8_LDB(B0, 0, 0); PG8_LDB(B1, 0, 1); PG8_SCHED; PG8_LDA(At, 0, 0); PG8_STAGE(PG8_SA(1, 1), a1 + hstepA, voffA);
            PG8_WAIT_V(8); PG8_WAIT_L(0); PG8_BAR; PG8_MMA(0, 0, At, B0); PG8_MMA(0, 1, At, B1); PG8_BAR; PG8_SCHED;
            PG8_LDA(At, 0, 1); PG8_STAGE(PG8_SB(0, 0), b2, voffB); PG8_STAGE(PG8_SB(0, 1), b2 + hstepB, voffB); PG8_STAGE(PG8_SA(0, 0), a2, voffA);
            PG8_WAIT_V(8); PG8_WAIT_L(0); PG8_BAR; PG8_MMA(1, 0, At, B0); PG8_MMA(1, 1, At, B1); PG8_BAR; PG8_SCHED;
            PG8_LDB(B0, 1, 0); PG8_LDB(B1, 1, 1); PG8_SCHED; PG8_LDA(At, 1, 0); PG8_STAGE(PG8_SA(0, 1), a2 + hstepA, voffA);
            PG8_WAIT_V(8); PG8_WAIT_L(0); PG8_BAR; PG8_MMA(0, 0, At, B0); PG8_MMA(0, 1, At, B1); PG8_BAR; PG8_SCHED;
            PG8_LDA(At, 1, 1); PG8_STAGE(PG8_SB(1, 0), b3, voffB); PG8_STAGE(PG8_SB(1, 1), b3 + hstepB, voffB); PG8_STAGE(PG8_SA(1, 0), a3, voffA);
            PG8_WAIT_V(8); PG8_WAIT_L(0); PG8_BAR; PG8_MMA(1, 0, At, B0); PG8_MMA(1, 1, At, B1); PG8_BAR; PG8_SCHED;
            } else {
            PG8_LDB(B0, 0, 0); PG8_SCHED; PG8_LDA(At, 0, 0); PG8_STAGE(PG8_SA(1, 1), a1 + hstepA, voffA);
            PG8_WAIT_L(8); PG8_BAR; PG8_WAIT_L(0); PG8_MMA(0, 0, At, B0); PG8_BAR; PG8_SCHED;
            PG8_LDB(B1, 0, 1); PG8_STAGE(PG8_SB(0, 0), b2, voffB);
            PG8_BAR; PG8_WAIT_L(0); PG8_MMA(0, 1, At, B1); PG8_BAR;
            PG8_LDA(At, 0, 1); PG8_STAGE(PG8_SA(0, 0), a2, voffA);
            PG8_BAR; PG8_WAIT_L(0); PG8_MMA(1, 0, At, B0); PG8_BAR; PG8_SCHED;
            PG8_STAGE(PG8_SB(0, 1), b2 + hstepB, voffB);
            PG8_WAIT_V(6); PG8_BAR; PG8_MMA(1, 1, At, B1); PG8_BAR;
            PG8_LDB(B0, 1, 0); PG8_SCHED; PG8_LDA(At, 1, 0); PG8_STAGE(PG8_SA(0, 1), a2 + hstepA, voffA);
            PG8_WAIT_L(8); PG8_BAR; PG8_WAIT_L(0); PG8_MMA(0, 0, At, B0); PG8_BAR; PG8_SCHED;
            PG8_LDB(B1, 1, 1); PG8_STAGE(PG8_SB(1, 0), b3, voffB);
            PG8_BAR; PG8_WAIT_L(0); PG8_MMA(0, 1, At, B1); PG8_BAR;
            PG8_LDA(At, 1, 1); PG8_STAGE(PG8_SA(1, 0), a3, voffA);
            PG8_BAR; PG8_WAIT_L(0); PG8_MMA(1, 0, At, B0); PG8_BAR; PG8_SCHED;
            PG8_STAGE(PG8_SB(1, 1), b3 + hstepB, voffB);
            PG8_WAIT_V(6); PG8_BAR; PG8_MMA(1, 1, At, B1); PG8_BAR;
            }
        }
        const bool fin = !Epi::GROUPED || cur.g == 7;
        if constexpr (ALIGN_EPI) { if (wr == 0 && fin) PG8_BAR; }
        if constexpr (Epi::GROUPED) {
            if (cur.g == 7) E(acc, cur, wr, wc, fr, fq);
            E.rescale(acc, lds, (ui >> 3) & 1, cur.g, wr, fr);
            if (cur.g == 7 && has_next) E.tile_begin(nxt, lds, ((ui >> 3) + 1) & 1, tid);
            S.done(cur); }
        else if constexpr (Epi::ROWTAB) { E.epi(acc, cur, lds, wr, wc, fr, fq); S.done(cur);
            if (has_next && nxt.pm != cur.pm) { PG8_BAR; E.row_table(nxt.pm, lds, tid); PG8_WAIT_L(0); PG8_BAR; } }
        else if constexpr (!Epi::AFTER_DRAIN) { E(acc, cur, wr, wc, fr, fq); S.done(cur); }
        if (!has_next) break;
        if constexpr (!Epi::GROUPED) {
#pragma unroll
        for (int a = 0; a < 2; ++a)
#pragma unroll
            for (int b = 0; b < 2; ++b)
#pragma unroll
                for (int m = 0; m < 4; ++m)
#pragma unroll
                    for (int n = 0; n < 2; ++n) acc[a][b][m][n] = (f32x4){0.f, 0.f, 0.f, 0.f};
        }
        cur = nxt; cA = nA; cB = nB; ++ui;
        if constexpr (ALIGN_EPI) { if (wr == 1 && fin) PG8_BAR; }
    }
    PG8_WAIT_V(0);
    if constexpr (!ALIGN_EPI) { if (wr == 0) PG8_BAR; }
    PG8_BAR;
    if constexpr (Epi::AFTER_DRAIN) { E.fused(acc, cur, wr, wc, fr, fq, lds, wid, lane); S.done(cur); }
#undef PG8_SA
#undef PG8_SB
#undef PG8_STAGE
#undef PG8_LDA
#undef PG8_LDB
#undef PG8_MMA
#undef PG8_WAIT_V
#undef PG8_WAIT_L
#undef PG8_BAR
#undef PG8_SCHED
}
}
#define GAS __attribute__((address_space(1)))
#define LAS __attribute__((address_space(3)))
typedef unsigned short bf16;
typedef unsigned v4u __attribute__((ext_vector_type(4)));
typedef float f32x4 __attribute__((ext_vector_type(4)));
typedef short bf16x8 __attribute__((ext_vector_type(8)));
typedef GAS unsigned gu32;
typedef GAS unsigned long long gu64;
#define RLX_AGENT __ATOMIC_RELAXED, __HIP_MEMORY_SCOPE_AGENT
#define LDS_WAIT() asm volatile("s_waitcnt lgkmcnt(0)" ::: "memory")
#define VM_WAIT() asm volatile("s_waitcnt vmcnt(0)" ::: "memory")
__device__ __forceinline__ unsigned long long rt() { return __builtin_amdgcn_s_memrealtime(); }
__device__ __forceinline__ unsigned f2bf(float f) { unsigned u = __builtin_bit_cast(unsigned, f); return (u + 0x7fffu + ((u >> 16) & 1u)) >> 16; }
typedef __bf16 bf16n2 __attribute__((ext_vector_type(2)));
__device__ __forceinline__ unsigned pk2(float lo, float hi) { const bf16n2 v = {(__bf16)lo, (__bf16)hi}; return __builtin_bit_cast(unsigned, v); }

#define XB_TMO      128
#define XB_XCNT(j)  (256  + 64 * (j))
#define XB_XSUB(j)  (1280 + 64 * (j))
#define XB_XGEN(j)  (2304 + 64 * (j))
#define XB_TOP      3328
#define XB_TOPGEN   3392
#define XCD_BAR_WORDS 3456
#define XB_SPIN_CAP (1u << 18)

__device__ __forceinline__ unsigned xb_ld(unsigned* p)              { return __hip_atomic_load(p, __ATOMIC_RELAXED, __HIP_MEMORY_SCOPE_AGENT); }
__device__ __forceinline__ unsigned xb_add(unsigned* p, unsigned v) { return __hip_atomic_fetch_add(p, v, __ATOMIC_RELAXED, __HIP_MEMORY_SCOPE_AGENT); }
__device__ __forceinline__ unsigned xb_xcc_id() { return (unsigned)__builtin_amdgcn_s_getreg((3 << 11) | 20) & 0xFu; }
#define XB_SPIN(cond, bar) do { unsigned _sp = 0; while (cond) { __builtin_amdgcn_s_sleep(1); \
    if ((++_sp & 255u) == 0u) { if (xb_ld(&(bar)[XB_TMO])) break; if (_sp > XB_SPIN_CAP) { atomicAdd(&(bar)[XB_TMO], 1u); break; } } } } while (0)

struct XcdBarrier {
    unsigned* bar; unsigned x;
    volatile LAS unsigned* st;
};

__device__ __forceinline__ XcdBarrier xcd_barrier_post(unsigned* bar, volatile LAS unsigned* st) {
    XcdBarrier b; b.bar = bar; b.x = xb_xcc_id(); b.st = st;
    if (threadIdx.x == 0) (void)xb_add(&bar[XB_XCNT(b.x)], 1u);
    return b;
}
__device__ __forceinline__ void xcd_barrier_complete(unsigned* bar, unsigned x, unsigned& nloc, unsigned& nx) {
    const unsigned G = gridDim.x * gridDim.y * gridDim.z;
    unsigned sum, cnt, mine, sp = 0u;
    for (;;) {
        sum = 0u; cnt = 0u; mine = 0u;
#pragma unroll
        for (unsigned j = 0; j < 16; ++j) { const unsigned c = xb_ld(&bar[XB_XCNT(j)]); sum += c; cnt += (c > 0u) ? 1u : 0u; mine = (j == x) ? c : mine; }
        if (sum == G) break;
        __builtin_amdgcn_s_sleep(1);
        if ((++sp & 255u) == 0u) { if (xb_ld(&bar[XB_TMO])) break; if (sp > XB_SPIN_CAP) { atomicAdd(&bar[XB_TMO], 1u); break; } }
    }
    nloc = mine > 0u ? mine : 1u; nx = cnt > 0u ? cnt : 1u;
}

__device__ __forceinline__ void xcd_barrier(const XcdBarrier& b) {
    asm volatile("s_waitcnt vmcnt(0)" ::: "memory");
    __syncthreads();
    if (threadIdx.x == 0) {
        unsigned* bar = b.bar;
        __builtin_amdgcn_s_waitcnt(0);
        unsigned nloc = b.st[0], nx = b.st[1];
        if (nloc == 0u) { xcd_barrier_complete(bar, b.x, nloc, nx); b.st[0] = nloc; b.st[1] = nx; }
        const unsigned old = xb_add(&bar[XB_XSUB(b.x)], 1u);
        const unsigned gen = old / nloc;
        if (old + 1u == (gen + 1u) * nloc) {
            __builtin_amdgcn_fence(__ATOMIC_RELEASE, "agent");
            asm volatile("s_waitcnt vmcnt(0)" ::: "memory");
            const unsigned og = xb_add(&bar[XB_TOP], 1u);
            const unsigned tg = og / nx;
            if (og + 1u == (tg + 1u) * nx) xb_add(&bar[XB_TOPGEN], 1u);
            else XB_SPIN(xb_ld(&bar[XB_TOPGEN]) == tg, bar);
            __builtin_amdgcn_fence(__ATOMIC_ACQUIRE, "agent");
            xb_add(&bar[XB_XGEN(b.x)], 1u);
            asm volatile("s_waitcnt vmcnt(0)" ::: "memory");
        } else {
            XB_SPIN(xb_ld(&bar[XB_XGEN(b.x)]) == gen, bar);
            __builtin_amdgcn_fence(__ATOMIC_ACQUIRE, "agent");
            asm volatile("s_waitcnt vmcnt(0)" ::: "memory");
        }
    }
    __syncthreads();
}
typedef float f32x2 __attribute__((ext_vector_type(2)));
constexpr int NWAVES = 8;
#ifndef MK_SPLIT
#define MK_SPLIT 0
#endif
constexpr int NPHASE = 19;

constexpr int M = 16384, T = 8192, D = 4096, DFF = 11008, GU_N = 2 * DFF;
constexpr int S_DI = 8192, S_CONV = 10240, S_IN = 18560, S_INP = 18688;
constexpr int G_PROJ = 12288, G_IN = 12304, G_INP = 12544;
constexpr float NORM_EPS = 1e-6f, INNER_EPS = 1e-5f;

constexpr size_t MiB = 1u << 20;
constexpr size_t WS_CTL = 0, CTL_ZERO_BYTES = 1 * MiB;
constexpr size_t WS_WIN = 2 * MiB;
constexpr size_t WS_WOUT0 = 148 * MiB;
constexpr size_t WS_WOUT1 = 100 * MiB;
constexpr size_t WS_WGU = 212 * MiB;
constexpr size_t WS_WDN = 384 * MiB;
constexpr size_t WS_XN = 470 * MiB;
constexpr size_t WS_R = 598 * MiB;
constexpr size_t WS_Z = WS_R, WS_XBC = WS_R + 256 * MiB, WS_XBC2 = WS_XBC + 320 * MiB, WS_DT = WS_XBC2 + 320 * MiB, WS_SSQ = WS_DT + 8 * MiB, WS_YG = WS_XBC;
constexpr size_t WS_ACT = WS_R;
constexpr size_t WS_PROJ = WS_R, WS_GKL = WS_R + 384 * MiB, WS_EE = WS_GKL + 1 * MiB, WS_QD = WS_GKL + 3 * MiB, WS_KI = WS_QD + 64 * MiB, WS_O = WS_KI + 64 * MiB, WS_SSQ2 = WS_O + 128 * MiB, WS_PB = WS_SSQ2 + 8 * MiB;
constexpr size_t WS_PSQ = 1510 * MiB, WS_RSTD = 1514 * MiB, WS_RAT = 1515 * MiB;
constexpr size_t WS2_WIN = 1516 * MiB, WS2_WOUT = WS2_WIN + 98 * MiB, WS2_WGU = WS2_WOUT + 32 * MiB, WS2_WDN = WS2_WGU + 172 * MiB;
constexpr size_t WS_DTP = WS2_WDN + 86 * MiB, WS_GKP = WS_DTP + 32 * MiB;
constexpr size_t WS_DUMMY = WS_GKP + 4 * MiB;
constexpr size_t WS_END = WS_DUMMY + 1 * MiB;
static_assert(WS_SSQ + 8 * MiB <= WS_END && WS_SSQ2 + 8 * MiB <= WS_END && WS_WIN + (size_t)S_INP * D * 2 <= WS_WOUT0 && WS_WOUT0 + (size_t)D * S_DI * 2 <= WS_WGU && WS_WGU + (size_t)GU_N * D * 2 <= WS_WDN && WS_WDN + (size_t)D * DFF * 2 <= WS_XN, "d_ws map");
static_assert(WS_WIN + (size_t)G_INP * D * 2 <= WS_WOUT1 && WS_WOUT1 + (size_t)D * D * 2 <= WS_WGU && WS_ACT + (size_t)M * DFF * 2 <= WS_O, "d_ws map 2");
constexpr int CW_BAR = 4096;

constexpr int RING_OFF = 0, RING_BYTES = 131072;
constexpr int LDSCTL_OFF = RING_BYTES, MISC_OFF = LDSCTL_OFF + 320;
constexpr int LDS_BYTES = 151552;

__device__ __forceinline__ float wave_sum(float v) {
#pragma unroll
    for (int o = 1; o < 64; o <<= 1) v += __shfl_xor(v, o);
    return v;
}
template <int CTRL> __device__ __forceinline__ float dpp_add(float v) { return v + __builtin_bit_cast(float, __builtin_amdgcn_update_dpp(0, __builtin_bit_cast(int, v), CTRL, 0xF, 0xF, true)); }
template <int CTRL, int ROWMASK> __device__ __forceinline__ float dpp_add_rm(float v) { return v + __builtin_bit_cast(float, __builtin_amdgcn_update_dpp(0, __builtin_bit_cast(int, v), CTRL, ROWMASK, 0xF, false)); }
__device__ __forceinline__ float wave_scan_incl(float v) {
    v = dpp_add<0x111>(v); v = dpp_add<0x112>(v); v = dpp_add<0x114>(v); v = dpp_add<0x118>(v);
    v = dpp_add_rm<0x142, 0xA>(v); v = dpp_add_rm<0x143, 0xC>(v); return v;
}
__device__ __forceinline__ float red4(float v) { v = dpp_add<0xB1>(v); v = dpp_add<0x4E>(v); return v; }
__device__ __forceinline__ float red8(float v) { v = red4(v); return dpp_add<0x141>(v); }
__device__ __forceinline__ float red16(float v) { v = red8(v); return dpp_add<0x140>(v); }
__device__ __forceinline__ float red32(float v) { v = red16(v); return v + __shfl_xor(v, 16); }
__device__ __forceinline__ void bf8_to_f32(const v4u u, float (&f)[8]) {
    f[0] = __builtin_bit_cast(float, u.x << 16); f[1] = __builtin_bit_cast(float, u.x & 0xffff0000u); f[2] = __builtin_bit_cast(float, u.y << 16); f[3] = __builtin_bit_cast(float, u.y & 0xffff0000u);
    f[4] = __builtin_bit_cast(float, u.z << 16); f[5] = __builtin_bit_cast(float, u.z & 0xffff0000u); f[6] = __builtin_bit_cast(float, u.w << 16); f[7] = __builtin_bit_cast(float, u.w & 0xffff0000u);
}
__device__ __forceinline__ float fexp(float x) { return __builtin_amdgcn_exp2f(x * 1.44269504f); }
__device__ __forceinline__ float silu(float v) { return v * __builtin_amdgcn_rcpf(1.0f + fexp(-v)); }
__device__ __forceinline__ float softplus(float x) { return fmaxf(x, 0.f) + log1pf(expf(-fabsf(x))); }

typedef short s16x4 __attribute__((ext_vector_type(4)));
typedef short v4i16_t __attribute__((ext_vector_type(4)));
typedef unsigned v2u __attribute__((ext_vector_type(2)));
__device__ __forceinline__ s16x4 lds_tr4(const LAS bf16* p) { return __builtin_bit_cast(s16x4, __builtin_amdgcn_ds_read_tr16_b64_v4i16((LAS v4i16_t*)p)); }
__device__ __forceinline__ bf16x8 frag_tr(const LAS bf16* T, int stride, int row0, int col0, int lane) {
    const LAS bf16* a = T + (row0 + 8 * (lane >> 4) + ((lane & 15) >> 2)) * stride + col0 + 4 * (lane & 3);
    const s16x4 lo = lds_tr4(a), hi = lds_tr4(a + 4 * stride);
    return (bf16x8){lo[0], lo[1], lo[2], lo[3], hi[0], hi[1], hi[2], hi[3]};
}
__device__ __forceinline__ bf16x8 frag_row(const LAS bf16* T, int stride, int row0, int k0, int lane) { return *(const LAS bf16x8*)(T + (row0 + (lane & 15)) * stride + k0 + 8 * (lane >> 4)); }
#define MFMA16(a, b, c) __builtin_amdgcn_mfma_f32_16x16x32_bf16(a, b, c, 0, 0, 0)

__device__ __forceinline__ void transpose_item(const float* W, int N, int K, bf16* WT, int k0, int n0, int ncols, int drow0, const float* gain, int gmask, LAS bf16* scr, int lane) {
    const int c4 = (lane & 15) * 4, kr = lane >> 4; const bool ok = c4 < ncols;
    f32x4 v[16];
#pragma unroll
    for (int i = 0; i < 16; ++i) v[i] = ok ? __builtin_nontemporal_load((const f32x4*)(W + (size_t)(k0 + 4 * i + kr) * N + n0 + c4)) : (f32x4){0.f, 0.f, 0.f, 0.f};
    if (gain) {
#pragma unroll
        for (int i = 0; i < 16; ++i) v[i] = v[i] * gain[(k0 + 4 * i + kr) & gmask];
    }
#pragma unroll
    for (int i = 0; i < 16; ++i) *(LAS v2u*)(scr + (4 * i + kr) * 72 + c4) = (v2u){pk2(v[i].x, v[i].y), pk2(v[i].z, v[i].w)};
    LDS_WAIT(); asm volatile("" ::: "memory");
#pragma unroll
    for (int rb = 0; rb < 2; ++rb)
#pragma unroll
        for (int cb = 0; cb < 4; ++cb) { const bf16x8 f = frag_tr(scr, 72, 32 * rb, 16 * cb, lane); const int n = 16 * cb + (lane & 15);
            if (n < ncols) *(bf16x8*)(WT + (size_t)(drow0 + n) * K + k0 + 32 * rb + 8 * (lane >> 4)) = f; }
    LDS_WAIT(); asm volatile("" ::: "memory");
}
struct WJob { const float* W; bf16* WT; int K, N, mode; const float* gain; int gmask; };
__device__ __forceinline__ int wjob_items(const WJob& j) { return (j.K / 64) * ((j.N + 63) / 64); }
__device__ __forceinline__ void wjob_item(const WJob& j, int r, LAS bf16* scr, int lane) {
    const int nblk = (j.N + 63) / 64, kb = r / nblk, nb = r - kb * nblk, n0 = 64 * nb, rem = j.N - n0, ncols = rem < 64 ? rem : 64;
    const int drow0 = j.mode == 0 ? n0 : ((n0 >> 7) * 256 + (n0 & 127) + (j.mode == 2 ? 128 : 0));
    transpose_item(j.W, j.N, j.K, j.WT, 64 * kb, n0, ncols, drow0, j.gain, j.gmask, scr, lane);
}
__device__ __forceinline__ void convert_layer(const WJob& j0, const WJob& j1, const WJob& j2, const WJob& j3, const WJob& j4, LAS bf16* scr, int widx, int nw, int lane, int lo = 0, int hi = -1) {
    const int i0 = wjob_items(j0), i1 = wjob_items(j1), i2 = wjob_items(j2), i3 = wjob_items(j3), i4 = wjob_items(j4);
    const int total = (hi < 0) ? (i0 + i1 + i2 + i3 + i4) : hi;
    for (int it = lo + widx; it < total; it += nw) {
        int r = it; WJob j = j0;
        if (r >= i0) { r -= i0; j = j1; if (r >= i1) { r -= i1; j = j2; if (r >= i2) { r -= i2; j = j3; if (r >= i3) { r -= i3; j = j4; } } } }
        wjob_item(j, r, scr, lane);
    }
}
__device__ __forceinline__ void zero_rows_bf16(bf16* p, size_t nelem, int gtid, int nthreads) {
    for (size_t i = (size_t)gtid * 8; i < nelem; i += (size_t)nthreads * 8) *(v4u*)(p + i) = (v4u){0u, 0u, 0u, 0u};
}
__device__ __forceinline__ void rmsnorm_row_bf16(const float* xrow, const float* w, bf16* orow, int lane) {
    const f32x4* xr = (const f32x4*)xrow + lane; f32x4 v[16]; float s = 0.f;
#pragma unroll
    for (int j = 0; j < 16; ++j) { v[j] = xr[64 * j]; s += (v[j].x * v[j].x + v[j].y * v[j].y) + (v[j].z * v[j].z + v[j].w * v[j].w); }
    const float rstd = 1.0f / sqrtf(wave_sum(s) * (1.f / D) + NORM_EPS);
    const f32x4* wr = (const f32x4*)w + lane; unsigned long long* o8 = (unsigned long long*)orow + lane;
#pragma unroll
    for (int j = 0; j < 16; ++j) { const f32x4 ww = wr[64 * j];
        o8[64 * j] = (unsigned long long)pk2(v[j].x * rstd * ww.x, v[j].y * rstd * ww.y) | ((unsigned long long)pk2(v[j].z * rstd * ww.z, v[j].w * rstd * ww.w) << 32); }
}
__device__ __forceinline__ void rmsnorm_row_from_bf16(const bf16* xrow, const float* w, float* orow, int lane) {
    float v[8][8]; float s = 0.f;
#pragma unroll
    for (int j = 0; j < 8; ++j) { bf8_to_f32(*(const v4u*)(xrow + (j * 64 + lane) * 8), v[j]);
#pragma unroll
        for (int e = 0; e < 8; ++e) s += v[j][e] * v[j][e]; }
    const float rstd = 1.0f / sqrtf(wave_sum(s) * (1.f / D) + NORM_EPS);
#pragma unroll
    for (int j = 0; j < 8; ++j) { const int c = (j * 64 + lane) * 8; const f32x4 w0 = *(const f32x4*)(w + c), w1 = *(const f32x4*)(w + c + 4);
        *(f32x4*)(orow + c) = (f32x4){v[j][0] * rstd * w0.x, v[j][1] * rstd * w0.y, v[j][2] * rstd * w0.z, v[j][3] * rstd * w0.w};
        *(f32x4*)(orow + c + 4) = (f32x4){v[j][4] * rstd * w1.x, v[j][5] * rstd * w1.y, v[j][6] * rstd * w1.z, v[j][7] * rstd * w1.w}; }
}
__device__ __forceinline__ void cast_row_rstd(const float* xrow, bf16* orow, float* rstd_out, int lane) {
    const f32x4* xr = (const f32x4*)xrow + lane; f32x4 v[16]; float s = 0.f;
#pragma unroll
    for (int j = 0; j < 16; ++j) { v[j] = xr[64 * j]; s += (v[j].x * v[j].x + v[j].y * v[j].y) + (v[j].z * v[j].z + v[j].w * v[j].w); }
    unsigned long long* o8 = (unsigned long long*)orow + lane;
#pragma unroll
    for (int j = 0; j < 16; ++j) o8[64 * j] = (unsigned long long)pk2(v[j].x, v[j].y) | ((unsigned long long)pk2(v[j].z, v[j].w) << 32);
    s = wave_sum(s); if (lane == 0) *rstd_out = 1.0f / sqrtf(s * (1.f / D) + NORM_EPS);
}
__device__ __forceinline__ void rstd_rows(const float* PSQ, float* RSTD, int gtid, int nthreads) {
    for (int i = gtid; i < M * 8; i += nthreads) { const f32x4 a = *(const f32x4*)(PSQ + (size_t)i * 8), b2 = *(const f32x4*)(PSQ + (size_t)i * 8 + 4);
        float s = (a.x + a.y) + (a.z + a.w) + (b2.x + b2.y) + (b2.z + b2.w); s = red8(s);
        if ((i & 7) == 0) RSTD[i >> 3] = 1.0f / sqrtf(s * (1.f / D) + NORM_EPS); }
}
__device__ __forceinline__ void ratio_rows(const float* ssq, float* RAT, float inv_n, int gtid, int nthreads) {
    for (int i = gtid; i < M * 8; i += nthreads) { const float* p = ssq + (size_t)i * 16;
        const f32x4 a = *(const f32x4*)p, b = *(const f32x4*)(p + 4), c = *(const f32x4*)(p + 8), d = *(const f32x4*)(p + 12); const f32x4 t = (a + b) + (c + d);
        const float sg = 1.0f / sqrtf(((t[0] + t[1]) + (t[2] + t[3])) * inv_n + INNER_EPS); const float sn = __shfl_down(sg, 1);
        RAT[i] = ((i & 7) == 7) ? sg : sg / sn; }
}
__device__ __forceinline__ void conv_item(const bf16* XBC, bf16* XBC2, const float* cw, const float* cb, int it, int lane) {
    const int tb = it / 20, cbk = it - tb * 20, m0 = tb * 32, c0 = cbk * 512 + lane * 8;
    float w[8][4], bias[8];
#pragma unroll
    for (int i = 0; i < 8; ++i) { const f32x4 ww = *(const f32x4*)(cw + (size_t)(c0 + i) * 4); w[i][0] = ww.x; w[i][1] = ww.y; w[i][2] = ww.z; w[i][3] = ww.w; }
    { const f32x4 b0 = *(const f32x4*)(cb + c0), b1 = *(const f32x4*)(cb + c0 + 4); bias[0] = b0.x; bias[1] = b0.y; bias[2] = b0.z; bias[3] = b0.w; bias[4] = b1.x; bias[5] = b1.y; bias[6] = b1.z; bias[7] = b1.w; }
    float h0[8], h1[8], h2[8];
    const bf16* src = XBC + (size_t)m0 * S_CONV + c0; bf16* dst = XBC2 + (size_t)m0 * S_CONV + c0;
    if ((m0 % T) == 0) {
#pragma unroll
        for (int i = 0; i < 8; ++i) { h0[i] = 0.f; h1[i] = 0.f; h2[i] = 0.f; }
    } else {
        bf8_to_f32(*(const v4u*)(src - 3 * (size_t)S_CONV), h0); bf8_to_f32(*(const v4u*)(src - 2 * (size_t)S_CONV), h1); bf8_to_f32(*(const v4u*)(src - 1 * (size_t)S_CONV), h2);
    }
    for (int r0 = 0; r0 < 32; r0 += 8) {
        v4u raw[8];
#pragma unroll
        for (int r = 0; r < 8; ++r) raw[r] = *(const v4u*)(src + (size_t)(r0 + r) * S_CONV);
#pragma unroll
        for (int r = 0; r < 8; ++r) {
            float cur[8], o[8]; bf8_to_f32(raw[r], cur);
#pragma unroll
            for (int i = 0; i < 8; ++i) { const float a = bias[i] + w[i][0] * h0[i] + w[i][1] * h1[i] + w[i][2] * h2[i] + w[i][3] * cur[i]; o[i] = silu(a); h0[i] = h1[i]; h1[i] = h2[i]; h2[i] = cur[i]; }
            v4u ov; ov.x = pk2(o[0], o[1]); ov.y = pk2(o[2], o[3]); ov.z = pk2(o[4], o[5]); ov.w = pk2(o[6], o[7]);
            *(v4u*)(dst + (size_t)(r0 + r) * S_CONV) = ov;
        }
    }
}
struct CvSet { float v[16]; };
struct CvPlan { const float *WA, *WG, *WU, *WD, *gA, *gGU, *dsrc; unsigned char* ws; };
template <class T_> __device__ __forceinline__ T_ sel(bool c, T_ a, T_ b) { return c ? a : b; }
struct CvState { const float *W, *gbase, *dsrc; bf16 *T, *ddst; int K, N, KB, gmask, kb, nb, K2; bool gu, up, has_gain, real; };
template <int LAYER> __device__ __forceinline__ CvState cv_init(const CvPlan& P, int s) {
    constexpr size_t oA = LAYER ? WS2_WOUT : WS_WOUT0, oGU = LAYER ? WS2_WGU : WS_WGU, oD = LAYER ? WS2_WDN : WS_WDN;
    constexpr int KA = LAYER ? 4096 : 8192, kshA = LAYER ? 8 : 9, gmaskA = LAYER ? 511 : -1;
    constexpr int nA = (KA >> 4) * 64, nG = 256 * 172, nranks = (nA + 3 * nG) / 128, n8 = (nranks - 1024) / 4;
    static_assert(128 * nranks == nA + 3 * nG && nA % 512 == 0 && nG % 512 == 0 && nranks >= 1024 && (nranks & 3) == 0 && n8 <= 256, "item count");
    const int wg = s >> 3, w = s & 7;
    const int rank = wg < n8 ? s : 8 * n8 + 4 * (wg - n8) + w;
    const int it = (rank >> 2) * 512 + (rank & 3);
    const bool isA = it < nA, isG = !isA && it < nA + nG, isU = !isA && !isG && it < nA + 2 * nG, isGU = isG || isU;
    const int r = isA ? it : isG ? it - nA : isU ? it - nA - nG : it - nA - 2 * nG;
    const int nbD = (int)((unsigned)r / 688u);
    CvState S; S.real = wg < n8 || w < 4;
    S.kb = isA ? (r & ((1 << kshA) - 1)) : isGU ? (r & 255) : r - nbD * 688;
    S.nb = isA ? (r >> kshA) : isGU ? (r >> 8) : nbD;
    S.KB = isA ? (KA >> 4) : isGU ? 256 : 688;
    S.K = isA ? KA : isGU ? 4096 : 11008; S.N = isGU ? 11008 : 4096; S.K2 = S.real ? S.K * 2 : 32;
    S.W = sel(isA, P.WA, sel(isG, P.WG, sel(isU, P.WU, P.WD))); S.gbase = sel(isA, P.gA, P.gGU); S.gmask = isA ? gmaskA : 4095;
    S.T = (bf16*)(P.ws + (isA ? oA : isGU ? oGU : oD)); S.gu = isGU; S.up = isU; S.has_gain = S.real && (isA || isGU);
    S.dsrc = P.dsrc; S.ddst = (bf16*)(P.ws + WS_DUMMY) + (s >> 3) * 1024;
    return S;
}
__device__ __forceinline__ void cv_issue(CvState& S, CvSet& V, float& gv, bf16*& dst, int lane) {
    const int k0 = S.kb * 16, n0 = S.nb * 64;
    const int drow0 = S.gu ? ((n0 >> 7) * 256 + (n0 & 127) + (S.up ? 128 : 0)) : n0;
    const float* src = sel(S.real, S.W + (size_t)k0 * S.N + n0, S.dsrc);
    const int Nl = S.real ? S.N : 0;
    dst = sel(S.real, S.T + (size_t)drow0 * S.K + k0, S.ddst);
#pragma unroll
    for (int j = 0; j < 16; ++j) V.v[j] = __builtin_nontemporal_load(src + (size_t)j * Nl + lane);
    gv = S.gbase[(k0 & S.gmask) + (lane & 15)];
    const bool wrap = S.kb + 4 >= S.KB; S.kb = wrap ? S.kb + 4 - S.KB : S.kb + 4; S.nb += wrap ? 1 : 0;
}
__device__ __forceinline__ void cv_finish(const CvSet& V, const float graw, bool has_gain, bf16* dst, int K2, int lane) {
    const float gv = has_gain ? graw : 1.0f;
    unsigned p[8];
#pragma unroll
    for (int j = 0; j < 8; ++j) {
        const float g0 = __builtin_bit_cast(float, __builtin_amdgcn_readlane(__builtin_bit_cast(int, gv), 2 * j)), g1 = __builtin_bit_cast(float, __builtin_amdgcn_readlane(__builtin_bit_cast(int, gv), 2 * j + 1));
        p[j] = pk2(V.v[2 * j] * g0, V.v[2 * j + 1] * g1); }
    unsigned char* o = (unsigned char*)dst + (unsigned)(lane * K2);
    *(v4u*)o = (v4u){p[0], p[1], p[2], p[3]}; *(v4u*)(o + 16) = (v4u){p[4], p[5], p[6], p[7]};
}

struct SsdRegs { v4u rB[2], rC[2], rX, rZ; float rdt; };
struct SsdCtx { const bf16* XBC2; const bf16* Z; const float* DTV; bf16* YG; float* SSQ; size_t mbase; int h, g, tid, lane, w, r16, q4, brow, bc8, xrow, xc8, pb, lb0; float a, dsk; };
__device__ __forceinline__ void ssd_load(SsdRegs& R, const SsdCtx& X, int cc) {
    const size_t m0 = X.mbase + (size_t)cc * 64;
#pragma unroll
    for (int i = 0; i < 2; ++i) { const bf16* p = X.XBC2 + (m0 + X.brow + 32 * i) * S_CONV + 8192 + X.g * 128 + X.bc8 * 8; R.rB[i] = *(const v4u*)p; R.rC[i] = *(const v4u*)(p + 1024); }
    R.rX = *(const v4u*)(X.XBC2 + (m0 + X.xrow) * S_CONV + X.h * 64 + X.xc8 * 8); R.rZ = *(const v4u*)(X.Z + (m0 + X.xrow) * S_DI + X.h * 64 + X.xc8 * 8);
    R.rdt = X.DTV[(m0 + X.lane) * 128 + X.h];
}
__device__ __forceinline__ void ssd_chunk_body(LAS unsigned char* lds, const SsdCtx& X, SsdRegs& R, f32x4 (&st)[4], int c, CvState& CS, CvSet& CI, float& gI, bf16*& dI, const CvSet& CF, const float gF, bf16* dF, int k2F) {
    constexpr int SB = 144, SX = 80, SY = 68;
    LAS bf16* Bs = (LAS bf16*)lds;
    LAS bf16* Cs = (LAS bf16*)(lds + 18432);
    LAS bf16* Xs = (LAS bf16*)(lds + 36864);
    LAS bf16* Xws = (LAS bf16*)(lds + 47104);
    LAS bf16* Ms = (LAS bf16*)(lds + 57344);
    LAS bf16* Sb0 = (LAS bf16*)(lds + 67584);
    LAS float* csA = (LAS float*)(lds + 104448); LAS float* dtA = csA + 64; LAS float* ecsA = csA + 128;
    LAS float* Ys = (LAS float*)(lds + 132096);
    LAS bf16* Zs = (LAS bf16*)(lds + 105216);
    const int lane = X.lane, w = X.w, r16 = X.r16, q4 = X.q4, brow = X.brow, bc8 = X.bc8, xrow = X.xrow, xc8 = X.xc8, pb = X.pb, lb0 = X.lb0, h = X.h;
    const float rdt = R.rdt;
    float cs = wave_scan_incl(rdt * X.a);
    const float cs_end = __builtin_bit_cast(float, __builtin_amdgcn_readlane(__builtin_bit_cast(int, cs), 63));
    const float wv = fexp(cs_end - cs) * rdt, e_end = fexp(cs_end);
    const float wl = __shfl(wv, xrow);
#pragma unroll
    for (int i = 0; i < 2; ++i) { *(LAS v4u*)(Bs + (brow + 32 * i) * SB + bc8 * 8) = R.rB[i]; *(LAS v4u*)(Cs + (brow + 32 * i) * SB + bc8 * 8) = R.rC[i]; }
    *(LAS v4u*)(Xs + xrow * SX + xc8 * 8) = R.rX; *(LAS v4u*)(Zs + xrow * SX + xc8 * 8) = R.rZ;
    { const unsigned xq[4] = {R.rX.x, R.rX.y, R.rX.z, R.rX.w}; const f32x2 wlv = {wl, wl}; unsigned xo[4];
#pragma unroll
      for (int p = 0; p < 4; ++p) { const f32x2 f = (f32x2){__builtin_bit_cast(float, xq[p] << 16), __builtin_bit_cast(float, xq[p] & 0xffff0000u)} * wlv; xo[p] = pk2(f.x, f.y); }
      *(LAS v4u*)(Xws + xrow * SX + xc8 * 8) = (v4u){xo[0], xo[1], xo[2], xo[3]}; }
    if (w == 0) { csA[lane] = cs; dtA[lane] = rdt; ecsA[lane] = fexp(cs); }
    const size_t m0 = X.mbase + (size_t)c * 64;
    __syncthreads();
    ssd_load(R, X, c + 2 < T / 64 ? c + 2 : T / 64 - 1);
    cv_issue(CS, CI, gI, dI, lane);
    const LAS bf16* Sc = Sb0 + (c & 1) * 9216; LAS bf16* Sn = Sb0 + ((c & 1) ^ 1) * 9216;
    for (int ti = w; ti < 10; ti += 8) {
        const int lb = ti >= 6 ? 3 : (ti >= 3 ? 2 : (ti >= 1 ? 1 : 0)), sb = ti - ((lb * (lb + 1)) >> 1);
        bf16x8 fb[4], fc[4];
#pragma unroll
        for (int kk = 0; kk < 4; ++kk) { fb[kk] = frag_row(Bs, SB, 16 * sb, 32 * kk, lane); fc[kk] = frag_row(Cs, SB, 16 * lb, 32 * kk, lane); }
        const float csl = csA[16 * lb + r16];
        const f32x4 css = *(const LAS f32x4*)(csA + 16 * sb + 4 * q4), dts = *(const LAS f32x4*)(dtA + 16 * sb + 4 * q4);
        __builtin_amdgcn_sched_barrier(0);
        f32x4 acc = (f32x4){0.f, 0.f, 0.f, 0.f};
#pragma unroll
        for (int kk = 0; kk < 4; ++kk) acc = MFMA16(fb[kk], fc[kk], acc);
        float m[4];
#pragma unroll
        for (int j = 0; j < 4; ++j) { const bool ok = (sb < lb) || (4 * q4 + j <= r16); m[j] = ok ? acc[j] * fexp(csl - css[j]) * dts[j] : 0.f; }
        *(LAS v2u*)(Ms + (16 * lb + r16) * SX + 16 * sb + 4 * q4) = (v2u){pk2(m[0], m[1]), pk2(m[2], m[3])};
    }
    f32x4 y0 = (f32x4){0.f, 0.f, 0.f, 0.f}, y1 = y0;
#pragma unroll
    for (int kk = 0; kk < 4; ++kk) { const bf16x8 af = frag_row(Sc, SB, 16 * pb, 32 * kk, lane);
        y0 = MFMA16(af, frag_row(Cs, SB, 16 * lb0, 32 * kk, lane), y0); y1 = MFMA16(af, frag_row(Cs, SB, 16 * lb0 + 16, 32 * kk, lane), y1); }
    { const float e0 = ecsA[16 * lb0 + r16], e1 = ecsA[16 * lb0 + 16 + r16]; y0 = y0 * e0; y1 = y1 * e1; }
#pragma unroll
    for (int i = 0; i < 4; ++i) st[i] = st[i] * e_end;
#pragma unroll
    for (int kl = 0; kl < 2; ++kl) { const bf16x8 af = frag_tr(Bs, SB, 32 * kl, 16 * w, lane);
#pragma unroll
        for (int i = 0; i < 4; ++i) st[i] = MFMA16(af, frag_tr(Xws, SX, 32 * kl, 16 * i, lane), st[i]); }
#pragma unroll
    for (int i = 0; i < 4; ++i) *(LAS v2u*)(Sn + (16 * i + r16) * SB + 16 * w + 4 * q4) = (v2u){pk2(st[i][0], st[i][1]), pk2(st[i][2], st[i][3])};
    __syncthreads();
    for (int ks = 0; ks <= (w >> 2); ++ks) { const bf16x8 af = frag_tr(Xs, SX, 32 * ks, 16 * pb, lane);
        y0 = MFMA16(af, frag_row(Ms, SX, 16 * lb0, 32 * ks, lane), y0); y1 = MFMA16(af, frag_row(Ms, SX, 16 * lb0 + 16, 32 * ks, lane), y1); }
    *(LAS f32x4*)(Ys + (16 * lb0 + r16) * SY + 16 * pb + 4 * q4) = y0; *(LAS f32x4*)(Ys + (16 * lb0 + 16 + r16) * SY + 16 * pb + 4 * q4) = y1;
    __syncthreads();
    { const v4u zr = *(const LAS v4u*)(Zs + xrow * SX + xc8 * 8), xr = *(const LAS v4u*)(Xs + xrow * SX + xc8 * 8);
      const f32x4 ya = *(const LAS f32x4*)(Ys + xrow * SY + xc8 * 8), yb = *(const LAS f32x4*)(Ys + xrow * SY + xc8 * 8 + 4);
      const unsigned zw[4] = {zr.x, zr.y, zr.z, zr.w}, xw4[4] = {xr.x, xr.y, xr.z, xr.w}; const f32x2 yv[4] = {{ya[0], ya[1]}, {ya[2], ya[3]}, {yb[0], yb[1]}, {yb[2], yb[3]}};
      const f32x2 dskv = {X.dsk, X.dsk}, nl2e = {-1.44269504f, -1.44269504f}, one = {1.0f, 1.0f}; f32x2 ssq2 = {0.f, 0.f}; unsigned ow[4];
#pragma unroll
      for (int p = 0; p < 4; ++p) { const f32x2 z = {__builtin_bit_cast(float, zw[p] << 16), __builtin_bit_cast(float, zw[p] & 0xffff0000u)}, xx = {__builtin_bit_cast(float, xw4[p] << 16), __builtin_bit_cast(float, xw4[p] & 0xffff0000u)};
          const f32x2 y = yv[p] + dskv * xx; const f32x2 t = z * nl2e; const f32x2 d = (f32x2){__builtin_amdgcn_exp2f(t.x), __builtin_amdgcn_exp2f(t.y)} + one;
          const f32x2 yg = (y * z) * (f32x2){__builtin_amdgcn_rcpf(d.x), __builtin_amdgcn_rcpf(d.y)};
          ssq2 = ssq2 + yg * yg; ow[p] = pk2(yg.x, yg.y); }
      float ssq = ssq2.x + ssq2.y;
      *(v4u*)(X.YG + (m0 + xrow) * S_DI + h * 64 + xc8 * 8) = (v4u){ow[0], ow[1], ow[2], ow[3]};
      ssq = red8(ssq); X.SSQ[(m0 + xrow) * 128 + h] = ssq; }
    cv_finish(CF, gF, CS.has_gain, dF, k2F, lane);
}
__device__ __forceinline__ void ssd_chunk_unit(LAS unsigned char* lds, int b, int h, const bf16* XBC2, const bf16* Z, const float* DTV, const float* a_log, const float* dskip, bf16* YG, float* SSQ, int tid, const CvPlan& P, int wg) {
    SsdCtx X; X.XBC2 = XBC2; X.Z = Z; X.DTV = DTV; X.YG = YG; X.SSQ = SSQ; X.mbase = (size_t)b * T; X.h = h; X.g = h >> 4; X.tid = tid; X.lane = tid & 63; X.w = __builtin_amdgcn_readfirstlane(tid >> 6);
    X.r16 = X.lane & 15; X.q4 = X.lane >> 4; X.brow = tid >> 4; X.bc8 = tid & 15; X.xrow = tid >> 3; X.xc8 = tid & 7; X.pb = X.w & 3; X.lb0 = 2 * (X.w >> 2); X.a = -expf(a_log[h]); X.dsk = dskip[h];
    __syncthreads();
    for (int i = tid; i < (10240 + 18432) / 16; i += 512) *(LAS v4u*)(lds + 57344 + i * 16) = (v4u){0u, 0u, 0u, 0u};
    f32x4 st[4];
#pragma unroll
    for (int i = 0; i < 4; ++i) st[i] = (f32x4){0.f, 0.f, 0.f, 0.f};
    SsdRegs RA, RB;
    ssd_load(RA, X, 0); ssd_load(RB, X, 1);
    CvState CS = cv_init<0>(P, wg * 8 + X.w);
    CvSet CA, CB; float gA = 0.f, gB = 0.f; bf16 *dA = CS.ddst, *dB = CS.ddst;
#pragma unroll
    for (int j = 0; j < 16; ++j) CB.v[j] = 0.f;
    ssd_chunk_body(lds, X, RA, st, 0, CS, CA, gA, dA, CB, gB, dB, 32); ssd_chunk_body(lds, X, RB, st, 1, CS, CB, gB, dB, CA, gA, dA, CS.K2);
    for (int c = 2; c < T / 64; c += 2) { ssd_chunk_body(lds, X, RA, st, c, CS, CA, gA, dA, CB, gB, dB, CS.K2); ssd_chunk_body(lds, X, RB, st, c + 1, CS, CB, gB, dB, CA, gA, dA, CS.K2); }
    cv_finish(CB, gB, CS.has_gain, dB, CS.K2, X.lane);
}
__device__ __forceinline__ void ssd_norm_row(bf16* yrow, const float* ssqrow, const float* nw, int lane) {
    float v = ssqrow[lane], w = ssqrow[64 + lane]; v = red16(v); w = red16(w);
    float rs[8];
#pragma unroll
    for (int gq = 0; gq < 4; ++gq) { rs[gq] = 1.0f / sqrtf(__shfl(v, 16 * gq) * (1.f / 1024.f) + INNER_EPS); rs[4 + gq] = 1.0f / sqrtf(__shfl(w, 16 * gq) * (1.f / 1024.f) + INNER_EPS); }
#pragma unroll
    for (int j = 0; j < 16; ++j) { const int c = (j * 64 + lane) * 8; float f[8]; bf8_to_f32(*(const v4u*)(yrow + c), f);
        const f32x4 w0 = *(const f32x4*)(nw + c), w1 = *(const f32x4*)(nw + c + 4); const float r = rs[j >> 1];
        v4u ov; ov.x = pk2(f[0] * r * w0.x, f[1] * r * w0.y); ov.y = pk2(f[2] * r * w0.z, f[3] * r * w0.w); ov.z = pk2(f[4] * r * w1.x, f[5] * r * w1.y); ov.w = pk2(f[6] * r * w1.z, f[7] * r * w1.w);
        *(v4u*)(yrow + c) = ov; }
}
__device__ __forceinline__ void gla_prep_chunk(const float* GKL, const float* gk_up, const float* gk_bias, const bf16* PROJ, bf16* QD, bf16* KI, float* EE, bf16* PB, LAS unsigned char* lds, int ch, int tid) {
    f32x4 up[16];
#pragma unroll
    for (int r = 0; r < 16; ++r) up[r] = *(const f32x4*)(gk_up + (size_t)r * 2048 + tid * 4);
    const f32x4 bias = *(const f32x4*)(gk_bias + tid * 4);
    f32x4 cs = (f32x4){0.f, 0.f, 0.f, 0.f};
    const size_t m0 = (size_t)ch * 64;
    LAS float* gls = (LAS float*)lds;
    for (int i = tid; i < 64 * 16; i += 512) { const float* g4 = GKL + m0 * 16 + i; gls[i] = (g4[0] + g4[(size_t)M * 16]) + (g4[(size_t)2 * M * 16] + g4[(size_t)3 * M * 16]); }
    __syncthreads();
#pragma unroll 2
    for (int l = 0; l < 64; ++l) {
        const size_t m = m0 + l;
        const LAS f32x4* gl = (const LAS f32x4*)(gls + l * 16); f32x4 z = bias;
#pragma unroll
        for (int r4 = 0; r4 < 4; ++r4) { const f32x4 gq = gl[r4]; z = z + up[4 * r4] * gq[0]; z = z + up[4 * r4 + 1] * gq[1]; z = z + up[4 * r4 + 2] * gq[2]; z = z + up[4 * r4 + 3] * gq[3]; }
        const v2u qr = *(const v2u*)(PROJ + m * G_PROJ + tid * 4), kr = *(const v2u*)(PROJ + m * G_PROJ + 2048 + tid * 4);
        float q[4], k[4];
        q[0] = __builtin_bit_cast(float, qr.x << 16); q[1] = __builtin_bit_cast(float, qr.x & 0xffff0000u); q[2] = __builtin_bit_cast(float, qr.y << 16); q[3] = __builtin_bit_cast(float, qr.y & 0xffff0000u);
        k[0] = __builtin_bit_cast(float, kr.x << 16); k[1] = __builtin_bit_cast(float, kr.x & 0xffff0000u); k[2] = __builtin_bit_cast(float, kr.y << 16); k[3] = __builtin_bit_cast(float, kr.y & 0xffff0000u);
        float qd[4], ki[4];
#pragma unroll
        for (int j = 0; j < 4; ++j) { const float ls = fminf(z[j], 0.f) - 0.693147181f * __builtin_amdgcn_logf(1.0f + fexp(-fabsf(z[j]))); cs[j] += ls * (1.f / 16.f); qd[j] = q[j] * 0.0625f * fexp(cs[j]); ki[j] = k[j] * fexp(-cs[j]); }
        *(v2u*)(QD + m * 2048 + tid * 4) = (v2u){pk2(qd[0], qd[1]), pk2(qd[2], qd[3])};
        *(v2u*)(KI + m * 2048 + tid * 4) = (v2u){pk2(ki[0], ki[1]), pk2(ki[2], ki[3])};
    }
    *(f32x4*)(EE + (size_t)ch * 2048 + tid * 4) = (f32x4){fexp(cs[0]), fexp(cs[1]), fexp(cs[2]), fexp(cs[3])};
    asm volatile("s_waitcnt vmcnt(0)" ::: "memory"); __syncthreads();
    { const int lane = tid & 63, w = __builtin_amdgcn_readfirstlane(tid >> 6), r16 = lane & 15, q4 = lane >> 4;
      const bf16* qb = QD + (m0 + r16) * 2048 + w * 256 + 8 * q4; const bf16* kb = KI + (m0 + r16) * 2048 + w * 256 + 8 * q4;
      bf16* pb = PB + ((size_t)(ch * 8 + w) * 64 + r16) * 64 + 4 * q4;
#pragma unroll 1
      for (int tl = 0; tl < 4; ++tl) {
          bf16x8 bq[8];
#pragma unroll
          for (int kk = 0; kk < 8; ++kk) bq[kk] = *(const bf16x8*)(qb + (size_t)(16 * tl) * 2048 + 32 * kk);
#pragma unroll 1
          for (int sb = 0; sb <= tl; ++sb) {
              f32x4 acc = (f32x4){0.f, 0.f, 0.f, 0.f};
#pragma unroll
              for (int kk = 0; kk < 8; ++kk) acc = MFMA16(*(const bf16x8*)(kb + (size_t)(16 * sb) * 2048 + 32 * kk), bq[kk], acc);
              float mm[4];
#pragma unroll
              for (int j = 0; j < 4; ++j) { const bool ok = (sb < tl) || (4 * q4 + j <= r16); mm[j] = ok ? acc[j] : 0.f; }
              *(v2u*)(pb + (size_t)(16 * tl) * 64 + 16 * sb) = (v2u){pk2(mm[0], mm[1]), pk2(mm[2], mm[3])};
          }
          if ((tl & 1) == 0) *(v2u*)(pb + (size_t)(16 * tl) * 64 + 16 * (tl + 1)) = (v2u){0u, 0u};
      }
    }
}
struct GlaRegs { v4u rQ[4], rK[4], rVG, rP; f32x4 rE; };
struct GlaCtx { const bf16* QD; const bf16* KI; const bf16* PROJ; const float* EE; const bf16* PB; bf16* O; float* SSQ2; size_t mbase; int b, h, sl, tid, lane, w, r16, q4, qrow, qc8, vrow, vc8, vb, lb, vgoff; };
__device__ __forceinline__ void gla_load(GlaRegs& R, const GlaCtx& X, int cc) {
    const size_t m0 = X.mbase + (size_t)cc * 64;
#pragma unroll
    for (int i = 0; i < 4; ++i) { const size_t o = (m0 + X.qrow + 16 * i) * 2048 + X.h * 256 + X.qc8 * 8; R.rQ[i] = *(const v4u*)(X.QD + o); R.rK[i] = *(const v4u*)(X.KI + o); }
    R.rVG = *(const v4u*)(X.PROJ + (m0 + X.vrow) * G_PROJ + X.vgoff + X.h * 512 + X.sl * 32 + X.vc8 * 8);
    R.rE = *(const f32x4*)(X.EE + (size_t)(X.b * (T / 64) + cc) * 2048 + X.h * 256 + X.lane * 4);
    R.rP = *(const v4u*)(X.PB + ((size_t)((X.b * (T / 64) + cc) * 8 + X.h) * 64 + (X.tid >> 3)) * 64 + (X.tid & 7) * 8);
}
__device__ __forceinline__ void gla_chunk_body(LAS unsigned char* lds, const GlaCtx& X, GlaRegs& R, f32x4 (&st)[2][2], int c) {
    constexpr int SQ = 272, SV = 40, SP = 80, SO = 36;
    LAS bf16* Qs = (LAS bf16*)lds;
    LAS bf16* Ks = (LAS bf16*)(lds + 34816);
    LAS bf16* Vs = (LAS bf16*)(lds + 69632);
    LAS bf16* Ps = (LAS bf16*)(lds + 74752);
    LAS bf16* Sb0 = (LAS bf16*)(lds + 84992);
    LAS float* Os = (LAS float*)(lds + 119808);
    LAS float* eA = (LAS float*)(lds + 129024);
    LAS bf16* Gs = (LAS bf16*)(lds + ((c & 1) ? 137216 : 132096));
    const int tid = X.tid, lane = X.lane, w = X.w, r16 = X.r16, q4 = X.q4, qrow = X.qrow, qc8 = X.qc8, vrow = X.vrow, vc8 = X.vc8, vb = X.vb, lb = X.lb, h = X.h, sl = X.sl;
#pragma unroll
    for (int i = 0; i < 4; ++i) { *(LAS v4u*)(Qs + (qrow + 16 * i) * SQ + qc8 * 8) = R.rQ[i]; *(LAS v4u*)(Ks + (qrow + 16 * i) * SQ + qc8 * 8) = R.rK[i]; }
    *(LAS v4u*)((tid < 256 ? Vs : Gs) + vrow * SV + vc8 * 8) = R.rVG;
    if (tid < 64) *(LAS f32x4*)(eA + tid * 4) = R.rE;
    *(LAS v4u*)(Ps + (tid >> 3) * SP + (tid & 7) * 8) = R.rP;
    const size_t m0 = X.mbase + (size_t)c * 64;
    __syncthreads();
    gla_load(R, X, c + 2 < T / 64 ? c + 2 : T / 64 - 1);
    const LAS bf16* Sc = Sb0 + (c & 1) * 8704; LAS bf16* Sn = Sb0 + ((c & 1) ^ 1) * 8704;
    f32x4 o = (f32x4){0.f, 0.f, 0.f, 0.f};
#pragma unroll
    for (int kk = 0; kk < 8; ++kk) o = MFMA16(frag_row(Sc, SQ, 16 * vb, 32 * kk, lane), frag_row(Qs, SQ, 16 * lb, 32 * kk, lane), o);
    for (int ks = 0; ks <= (lb >> 1); ++ks) o = MFMA16(frag_tr(Vs, SV, 32 * ks, 16 * vb, lane), frag_row(Ps, SP, 16 * lb, 32 * ks, lane), o);
    *(LAS f32x4*)(Os + (16 * lb + r16) * SO + 16 * vb + 4 * q4) = o;
#pragma unroll
    for (int kl = 0; kl < 2; ++kl) { const bf16x8 bv0 = frag_tr(Vs, SV, 32 * kl, 0, lane), bv1 = frag_tr(Vs, SV, 32 * kl, 16, lane);
#pragma unroll
        for (int i = 0; i < 2; ++i) { const bf16x8 af = frag_tr(Ks, SQ, 32 * kl, 16 * (2 * w + i), lane); st[i][0] = MFMA16(af, bv0, st[i][0]); st[i][1] = MFMA16(af, bv1, st[i][1]); } }
#pragma unroll
    for (int i = 0; i < 2; ++i) { const f32x4 e = *(const LAS f32x4*)(eA + 16 * (2 * w + i) + 4 * q4); st[i][0] = st[i][0] * e; st[i][1] = st[i][1] * e;
#pragma unroll
        for (int v2 = 0; v2 < 2; ++v2) *(LAS v2u*)(Sn + (16 * v2 + r16) * SQ + 16 * (2 * w + i) + 4 * q4) = (v2u){pk2(st[i][v2][0], st[i][v2][1]), pk2(st[i][v2][2], st[i][v2][3])}; }
    __syncthreads();
    { const int erow = tid >> 3, ec4 = tid & 7;
        const f32x4 oa = *(const LAS f32x4*)(Os + erow * SO + ec4 * 4); const v2u gr = *(const LAS v2u*)(Gs + erow * SV + ec4 * 4);
        float ssq = (oa[0] * oa[0] + oa[1] * oa[1]) + (oa[2] * oa[2] + oa[3] * oa[3]);
        const float g0 = __builtin_bit_cast(float, gr.x << 16), g1 = __builtin_bit_cast(float, gr.x & 0xffff0000u), g2 = __builtin_bit_cast(float, gr.y << 16), g3 = __builtin_bit_cast(float, gr.y & 0xffff0000u);
        *(v2u*)(X.O + (m0 + erow) * D + h * 512 + sl * 32 + ec4 * 4) = (v2u){pk2(oa[0] * silu(g0), oa[1] * silu(g1)), pk2(oa[2] * silu(g2), oa[3] * silu(g3))};
        ssq = red8(ssq); X.SSQ2[(m0 + erow) * 128 + h * 16 + sl] = ssq; }
}
__device__ __forceinline__ void gla_chunk_unit(LAS unsigned char* lds, int b, int h, int sl, const bf16* QD, const bf16* KI, const bf16* PROJ, const float* EE, const bf16* PB, bf16* O, float* SSQ2, int tid) {
    GlaCtx X; X.QD = QD; X.KI = KI; X.PROJ = PROJ; X.EE = EE; X.PB = PB; X.O = O; X.SSQ2 = SSQ2; X.mbase = (size_t)b * T; X.b = b; X.h = h; X.sl = sl; X.tid = tid; X.lane = tid & 63; X.w = __builtin_amdgcn_readfirstlane(tid >> 6);
    X.r16 = X.lane & 15; X.q4 = X.lane >> 4; X.qrow = tid >> 5; X.qc8 = tid & 31; X.vrow = (tid >> 2) & 63; X.vc8 = tid & 3; X.vb = X.w & 1; X.lb = X.w >> 1; X.vgoff = tid < 256 ? 4096 : 8192;
    __syncthreads();
    for (int i = tid; i < 17408 / 16; i += 512) *(LAS v4u*)(lds + 84992 + i * 16) = (v4u){0u, 0u, 0u, 0u};
    f32x4 st[2][2];
#pragma unroll
    for (int i = 0; i < 2; ++i) { st[i][0] = (f32x4){0.f, 0.f, 0.f, 0.f}; st[i][1] = st[i][0]; }
    GlaRegs RA, RB;
    gla_load(RA, X, 0); gla_load(RB, X, 1);
    gla_chunk_body(lds, X, RA, st, 0); gla_chunk_body(lds, X, RB, st, 1);
    for (int c = 2; c < T / 64; c += 2) { gla_chunk_body(lds, X, RA, st, c); gla_chunk_body(lds, X, RB, st, c + 1); }
}
__device__ __forceinline__ void gla_norm_row(bf16* orow, const bf16* grow, const float* ssqrow, const float* nw, int lane) {
    float v = ssqrow[lane], w = ssqrow[64 + lane]; v = red16(v); w = red16(w);
    float rs[8];
#pragma unroll
    for (int gq = 0; gq < 4; ++gq) { rs[gq] = 1.0f / sqrtf(__shfl(v, 16 * gq) * (1.f / 512.f) + INNER_EPS); rs[4 + gq] = 1.0f / sqrtf(__shfl(w, 16 * gq) * (1.f / 512.f) + INNER_EPS); }
#pragma unroll
    for (int j = 0; j < 8; ++j) { const int c = (j * 64 + lane) * 8; float f[8], gt[8]; bf8_to_f32(*(const v4u*)(orow + c), f); bf8_to_f32(*(const v4u*)(grow + c), gt);
        const f32x4 w0 = *(const f32x4*)(nw + (c & 511)), w1 = *(const f32x4*)(nw + (c & 511) + 4); const float r = rs[j];
        v4u ov; ov.x = pk2(f[0] * r * w0.x * silu(gt[0]), f[1] * r * w0.y * silu(gt[1])); ov.y = pk2(f[2] * r * w0.z * silu(gt[2]), f[3] * r * w0.w * silu(gt[3]));
        ov.z = pk2(f[4] * r * w1.x * silu(gt[4]), f[5] * r * w1.y * silu(gt[5])); ov.w = pk2(f[6] * r * w1.z * silu(gt[6]), f[7] * r * w1.w * silu(gt[7]));
        *(v4u*)(orow + c) = ov; }
}

struct Args { const float* in[25]; float* out; unsigned char* ws; int ph_lo, ph_hi; };
__global__ void __launch_bounds__(NWAVES * 64, 2) trunk_fwd(Args args) {
    extern __shared__ __attribute__((aligned(16))) unsigned char lds_raw[];
    LAS unsigned char* lds = (LAS unsigned char*)lds_raw;
    volatile LAS unsigned* MISC = (volatile LAS unsigned*)(lds + MISC_OFF);
    const int tid = threadIdx.x, lane = tid & 63, wave = __builtin_amdgcn_readfirstlane(tid >> 6);
    const int G = gridDim.x, bx = blockIdx.x;
    const int vcu = (G % 8 == 0) ? (bx % 8) * (G / 8) + bx / 8 : bx;
    const int gw = vcu * NWAVES + wave, NGW = G * NWAVES;
    unsigned char* ws = args.ws;
    const int lo = args.ph_lo, hi = args.ph_hi;
    for (int u = tid; u < (LDS_BYTES - LDSCTL_OFF) / 4; u += NWAVES * 64) ((LAS unsigned*)(lds + LDSCTL_OFF))[u] = 0u;
    __syncthreads();
    XcdBarrier bar; bar.bar = (unsigned*)(ws + WS_CTL) + CW_BAR; bar.x = 0; bar.st = nullptr;
    if (hi - lo > 1) bar = xcd_barrier_post((unsigned*)(ws + WS_CTL) + CW_BAR, MISC + 8);
#define IN(k) (lo <= (k) && (k) < hi)
#define SEAM(k) do { if (IN(k) && IN((k) + 1)) xcd_barrier(bar); } while (0)
    const float* x = args.in[0];
    const float *l0_mixer_norm = args.in[1], *l0_in_proj = args.in[2], *l0_conv_w = args.in[3], *l0_conv_b = args.in[4], *l0_dt_bias = args.in[5], *l0_a_log = args.in[6], *l0_d = args.in[7],
                *l0_norm_w = args.in[8], *l0_out_proj = args.in[9], *l0_ffn_norm = args.in[10], *l0_w_gate = args.in[11], *l0_w_up = args.in[12], *l0_w_down = args.in[13];
    const float *l1_mixer_norm = args.in[14], *l1_in_proj = args.in[15], *l1_gk_up = args.in[16], *l1_gk_bias = args.in[17], *l1_norm_w = args.in[18], *l1_out_proj = args.in[19],
                *l1_ffn_norm = args.in[20], *l1_w_gate = args.in[21], *l1_w_up = args.in[22], *l1_w_down = args.in[23], *final_norm = args.in[24];
    float* out = args.out;
    bf16 *WIN = (bf16*)(ws + WS_WIN), *WOUT0 = (bf16*)(ws + WS_WOUT0), *WOUT1 = (bf16*)(ws + WS_WOUT1), *WGU = (bf16*)(ws + WS_WGU), *WDN = (bf16*)(ws + WS_WDN), *XN = (bf16*)(ws + WS_XN);
    bf16 *Zb = (bf16*)(ws + WS_Z), *XBC = (bf16*)(ws + WS_XBC), *XBC2 = (bf16*)(ws + WS_XBC2), *YG = (bf16*)(ws + WS_YG), *ACT = (bf16*)(ws + WS_ACT), *PROJ = (bf16*)(ws + WS_PROJ), *Ob = (bf16*)(ws + WS_O), *QD = (bf16*)(ws + WS_QD), *KI = (bf16*)(ws + WS_KI), *PBb = (bf16*)(ws + WS_PB);
    bf16 *WIN1 = (bf16*)(ws + WS2_WIN), *WOUT1b = (bf16*)(ws + WS2_WOUT), *WGU1 = (bf16*)(ws + WS2_WGU), *WDN1 = (bf16*)(ws + WS2_WDN);
    const WJob k0{l1_in_proj, WIN1, D, G_IN, 0, l1_mixer_norm, -1}, k1{l1_out_proj, WOUT1b, D, D, 0, l1_norm_w, 511}, k2{l1_w_gate, WGU1, D, DFF, 1, l1_ffn_norm, -1}, k3{l1_w_up, WGU1, D, DFF, 2, l1_ffn_norm, -1}, k4{l1_w_down, WDN1, DFF, D, 0, nullptr, -1};
    constexpr int L1_ITEMS_B = 12288;
    float *DTP = (float*)(ws + WS_DTP), *GKP = (float*)(ws + WS_GKP);
    bf16* XR = XN;
    float *PSQ = (float*)(ws + WS_PSQ), *RSTD = (float*)(ws + WS_RSTD), *RAT = (float*)(ws + WS_RAT);
    float *DT = (float*)(ws + WS_DT), *SSQ = (float*)(ws + WS_SSQ), *EE = (float*)(ws + WS_EE), *SSQ2 = (float*)(ws + WS_SSQ2);
    LAS bf16* scr = (LAS bf16*)(lds + RING_OFF + wave * 16384);

    if (IN(0)) {
        const WJob j0{l0_in_proj, WIN, D, S_IN, 0, l0_mixer_norm, -1}, j1{l0_out_proj, WOUT0, S_DI, D, 0, l0_norm_w, -1}, j2{l0_w_gate, WGU, D, DFF, 1, l0_ffn_norm, -1}, j3{l0_w_up, WGU, D, DFF, 2, l0_ffn_norm, -1}, j4{l0_w_down, WDN, DFF, D, 0, nullptr, -1};
        convert_layer(j0, j1, j2, j3, j4, scr, gw, NGW, lane, 0, wjob_items(j0));
        zero_rows_bf16(WIN + (size_t)S_IN * D, (size_t)(S_INP - S_IN) * D, vcu * 512 + tid, G * 512);
        for (int m = gw; m < M; m += NGW) cast_row_rstd(x + (size_t)m * D, XR + (size_t)m * D, RSTD + m, lane);
    }
    SEAM(0);
    if (IN(1)) {
        pg8::Gemm g{XN, WIN, M, 72 * 256, D, D, D}; pg8::StaticOrder S; S.init(M, 72 * 256, G, bx);
        pg8::EpiSsdIn E{Zb, XBC, RSTD};
        pg8::gemm_phase<pg8::EpiSsdIn, pg8::StaticOrder, true, true>(lds + RING_OFF, g, S, E);
        pg8::Gemm g2{XN, WIN, M, 256, D / 4, D, D}; pg8::KSplitOrder S2; S2.init(M, G, bx, 72, D / 4);
        pg8::EpiDtPart E2{DTP, RSTD};
        pg8::gemm_phase<pg8::EpiDtPart, pg8::KSplitOrder, true, true>(lds + RING_OFF, g2, S2, E2);
    }
    SEAM(1);
    if (IN(2)) {
        for (int it = gw; it < (M / 32) * 20; it += NGW) conv_item(XBC, XBC2, l0_conv_w, l0_conv_b, it, lane);
        for (int i = vcu * 512 + tid; i < M * 128 / 4; i += G * 512) { const f32x4 bb = *(const f32x4*)(l0_dt_bias + ((i * 4) & 127));
            f32x4 v = (*(const f32x4*)(DTP + (size_t)i * 4) + *(const f32x4*)(DTP + (size_t)M * 128 + (size_t)i * 4)) + (*(const f32x4*)(DTP + (size_t)2 * M * 128 + (size_t)i * 4) + *(const f32x4*)(DTP + (size_t)3 * M * 128 + (size_t)i * 4));
            v = (f32x4){softplus(v.x + bb.x), softplus(v.y + bb.y), softplus(v.z + bb.z), softplus(v.w + bb.w)}; *(f32x4*)(DT + (size_t)i * 4) = v; }
    }
    SEAM(2);
    if (IN(3)) {
        const CvPlan P0{l0_out_proj, l0_w_gate, l0_w_up, l0_w_down, l0_norm_w, l0_ffn_norm, l0_a_log, ws};
        for (int u = bx; u < 256; u += G) { const int xcd = u & 7, j = u >> 3, pair = xcd * 2 + (j >> 4), b = pair >> 3, gq = pair & 7, r = j & 15;
            ssd_chunk_unit(lds + RING_OFF, b, gq * 16 + r, XBC2, Zb, DT, l0_a_log, l0_d, YG, SSQ, tid, P0, u); __syncthreads(); }
    }
    SEAM(3);
    if (IN(4)) ratio_rows(SSQ, RAT, 1.f / 1024.f, vcu * 512 + tid, G * 512);
    SEAM(4);
    if (IN(5)) {
        pg8::Gemm g{YG, WOUT0, M, D, 1024, S_DI, S_DI}; pg8::GroupedOrder S; S.init(M, D, G, bx, 1024);
        pg8::EpiResBf16<false, true> E{XR, XR, PSQ, RAT};
        pg8::gemm_phase<pg8::EpiResBf16<false, true>, pg8::GroupedOrder, true, true>(lds + RING_OFF, g, S, E);
    }
    SEAM(5);
    if (IN(7)) {
        pg8::Gemm g{XR, WGU, M, GU_N, D, D, D}; pg8::StaticOrder S; S.init(M, GU_N, G, bx);
        pg8::EpiSwiGLU E{ACT, DFF, PSQ};
        pg8::gemm_phase<pg8::EpiSwiGLU, pg8::StaticOrder, true, true>(lds + RING_OFF, g, S, E);
        { const int nextra = S.nwg % G; if (nextra && bx >= nextra) convert_layer(k0, k1, k2, k3, k4, scr, (bx - nextra) * NWAVES + wave, (G - nextra) * NWAVES, lane, 0, L1_ITEMS_B); }
    }
    SEAM(7);
    if (IN(8)) {
        pg8::Gemm g{ACT, WDN, M, D, DFF, DFF, DFF}; pg8::StaticOrder S; S.init(M, D, G, bx);
        pg8::EpiResBf16<false, false> E{XR, XR, PSQ, nullptr};
        pg8::gemm_phase<pg8::EpiResBf16<false, false>, pg8::StaticOrder, true, true>(lds + RING_OFF, g, S, E);
    }
    if (IN(9)) {
        convert_layer(k0, k1, k2, k3, k4, scr, gw, NGW, lane, L1_ITEMS_B, wjob_items(k0) + wjob_items(k1) + wjob_items(k2) + wjob_items(k3));
        zero_rows_bf16(WIN1 + (size_t)G_IN * D, (size_t)(G_INP - G_IN) * D, vcu * 512 + tid, G * 512);
    }
    SEAM(9);
    if (IN(10)) {
        pg8::Gemm g{XR, WIN1, M, G_PROJ, D, D, D}; pg8::StaticOrder S; S.init(M, G_PROJ, G, bx);
        pg8::EpiGlaIn E{PROJ, PSQ};
        pg8::gemm_phase<pg8::EpiGlaIn, pg8::StaticOrder, true, true>(lds + RING_OFF, g, S, E);
        pg8::Gemm g2{XR, WIN1, M, 256, D / 4, D, D}; pg8::KSplitOrder S2; S2.init(M, G, bx, 48, D / 4);
        pg8::EpiGkPart E2{GKP, PSQ};
        pg8::gemm_phase<pg8::EpiGkPart, pg8::KSplitOrder, true, true>(lds + RING_OFF, g2, S2, E2);
    }
    SEAM(10);
    if (IN(11)) { for (int ch = vcu; ch < M / 64; ch += G) gla_prep_chunk(GKP, l1_gk_up, l1_gk_bias, PROJ, QD, KI, EE, PBb, lds + RING_OFF, ch, tid); __syncthreads(); }
    SEAM(11);
    if (IN(12)) {
        for (int u = bx; u < 256; u += G) { const int xcd = u & 7, j = u >> 3, pair = xcd * 2 + (j >> 4), b = pair >> 3, hh = pair & 7, sl = j & 15;
            gla_chunk_unit(lds + RING_OFF, b, hh, sl, QD, KI, PROJ, EE, PBb, Ob, SSQ2, tid); __syncthreads(); }
    }
    SEAM(12);
    if (IN(13)) ratio_rows(SSQ2, RAT, 1.f / 512.f, vcu * 512 + tid, G * 512);
    SEAM(13);
    if (IN(14)) {
        pg8::Gemm g{Ob, WOUT1b, M, D, 512, D, D}; pg8::GroupedOrder S; S.init(M, D, G, bx, 512);
        pg8::EpiResBf16<false, true> E{XR, XR, PSQ, RAT};
        pg8::gemm_phase<pg8::EpiResBf16<false, true>, pg8::GroupedOrder, true, true>(lds + RING_OFF, g, S, E);
    }
    SEAM(14);
    if (IN(16)) {
        pg8::Gemm g{XR, WGU1, M, GU_N, D, D, D}; pg8::StaticOrder S; S.init(M, GU_N, G, bx);
        pg8::EpiSwiGLU E{ACT, DFF, PSQ};
        pg8::gemm_phase<pg8::EpiSwiGLU, pg8::StaticOrder, true, true>(lds + RING_OFF, g, S, E);
        { const int nextra = S.nwg % G; if (nextra && bx >= nextra) convert_layer(k4, k4, k4, k4, k4, scr, (bx - nextra) * NWAVES + wave, (G - nextra) * NWAVES, lane, 0, wjob_items(k4));
          else if (!nextra) convert_layer(k4, k4, k4, k4, k4, scr, gw, NGW, lane, 0, wjob_items(k4)); }
    }
    SEAM(16);
    if (IN(17)) {
        pg8::Gemm g{ACT, WDN1, M, D, DFF, DFF, DFF}; pg8::StaticOrder S; S.init(M, D, G, bx);
        pg8::EpiResBf16<false, false> E{XR, XR, PSQ, nullptr};
        pg8::gemm_phase<pg8::EpiResBf16<false, false>, pg8::StaticOrder, true, true>(lds + RING_OFF, g, S, E);
    }
    SEAM(17);
    if (IN(18)) { for (int m = gw; m < M; m += NGW) rmsnorm_row_from_bf16(XR + (size_t)m * D, final_norm, out + (size_t)m * D, lane); }
#undef IN
#undef SEAM
}

extern "C" void kernel_launch(void* const* d_in, const int* in_sizes, int n_in, void* d_out, int out_size, void* d_ws, size_t ws_size, hipStream_t stream) {
    static int grid = 0;
    if (grid == 0) {
        if (n_in != 25 || in_sizes[0] != M * D || out_size != M * D || ws_size < WS_END) { fprintf(stderr, "kernel_launch: unexpected problem (n_in %d, in0 %d, out %d, ws %zu < %zu); nothing launched\n", n_in, n_in > 0 ? in_sizes[0] : -1, out_size, ws_size, (size_t)WS_END); grid = -1; return; }
        int dev = 0, cus = 0, per_cu = 0;
        if (hipGetDevice(&dev) != hipSuccess || hipDeviceGetAttribute(&cus, hipDeviceAttributeMultiprocessorCount, dev) != hipSuccess) { fprintf(stderr, "kernel_launch: device query failed\n"); grid = -1; return; }
        if (hipFuncSetAttribute((const void*)trunk_fwd, hipFuncAttributeMaxDynamicSharedMemorySize, LDS_BYTES) != hipSuccess) { fprintf(stderr, "kernel_launch: hipFuncSetAttribute failed\n"); grid = -1; return; }
        if (hipOccupancyMaxActiveBlocksPerMultiprocessor(&per_cu, (const void*)trunk_fwd, NWAVES * 64, LDS_BYTES) != hipSuccess || per_cu < 1)
            fprintf(stderr, "kernel_launch: note: occupancy query reports %d workgroups per CU\n", per_cu);
        (void)hipGetLastError();
        grid = cus;
    }
    if (grid < 0) return;
    if (hipMemsetAsync((char*)d_ws + WS_CTL, 0, CTL_ZERO_BYTES, stream) != hipSuccess) { fprintf(stderr, "kernel_launch: memset failed\n"); return; }
    Args a{};
    for (int i = 0; i < 25; ++i) a.in[i] = (const float*)d_in[i];
    a.out = (float*)d_out; a.ws = (unsigned char*)d_ws;
#if MK_SPLIT
    for (int p = 0; p < NPHASE; ++p) { a.ph_lo = p; a.ph_hi = p + 1; hipLaunchKernelGGL(trunk_fwd, dim3(grid), dim3(NWAVES * 64), LDS_BYTES, stream, a); }
#else
    a.ph_lo = 0; a.ph_hi = NPHASE;
    hipLaunchKernelGGL(trunk_fwd, dim3(grid), dim3(NWAVES * 64), LDS_BYTES, stream, a);
#endif
    const hipError_t le = hipPeekAtLastError();
    if (le != hipSuccess) fprintf(stderr, "kernel_launch: launch failed: %s\n", hipGetErrorName(le));
}
```

```cpp
#include <hip/hip_runtime.h>
#include <cstdio>
#include <cstdint>
namespace pg8 {
#define PG8_LAS __attribute__((address_space(3)))
typedef unsigned short bf16_t;
typedef short bf16x8 __attribute__((ext_vector_type(8)));
typedef float f32x4 __attribute__((ext_vector_type(4)));
typedef unsigned u32x4 __attribute__((ext_vector_type(4)));
constexpr int BM = 256, BK = 64, HALF = 128, HTB = HALF * BK * 2  , STAGE_BYTES = 8 * HTB, NXCD = 8, WGM = 8;

__host__ __device__ __forceinline__ int lds_byte(int r, int c) { const int st = (r >> 4) * 2 + (c >> 5), rr = r & 15, cc = c & 31, ob = rr * 64 + cc * 2; return st * 1024 + (ob ^ (((ob >> 9) & 1) << 5)); }
__host__ __device__ __forceinline__ void stage_rc(int b, int& R, int& C) { const int st = b / 1024, sb = b % 1024, swz = sb ^ (((sb >> 9) & 1) << 5); R = (st >> 1) * 16 + swz / 64; C = (st & 1) * 32 + (swz % 64) / 2; }
__host__ __device__ __forceinline__ int perm32(int rho) { const int n = rho >> 4, i = rho & 15; return 8 * (i >> 2) + 4 * n + (i & 3); }

struct Unit { int pm, pn, g; };
struct Gemm { const bf16_t* A; const bf16_t* Bt; int M, N, K, lda, ldb; };

struct StaticOrder {
    int nM, nN, nwg, G, c;
    __host__ __device__ void init(int M, int N, int G_, int c_) { nM = M / BM; nN = N / BM; nwg = nM * nN; G = G_; c = c_; }
    __host__ __device__ bool next(int i, Unit& u) const {
        const long L = (long)i * G + c; if (L >= nwg) return false;
        int wgid = (int)L; { const int q = nwg / NXCD, r = nwg % NXCD, xcd = wgid % NXCD, off = wgid / NXCD; wgid = (xcd < r ? xcd * (q + 1) : r * (q + 1) + (xcd - r) * q) + off; }
        const int nig = WGM * nN, gid = wgid / nig, fm = gid * WGM, gsz = (nM - fm) < WGM ? (nM - fm) : WGM;
        u.pm = fm + ((wgid % nig) % gsz); u.pn = (wgid % nig) / gsz; u.g = 0; return true;
    }
    __device__ __forceinline__ size_t aoff(const Unit& u, int lda) const { return (size_t)u.pm * BM * lda * 2; }
    __device__ __forceinline__ size_t boff(const Unit& u, int ldb) const { return (size_t)u.pn * BM * ldb * 2; }
    __device__ __forceinline__ void a_ready(const Unit&) const {}
    __device__ __forceinline__ void done(const Unit&) const {}
};
struct GroupedOrder {
    StaticOrder base; int kg;
    __host__ __device__ void init(int M, int N, int G_, int c_, int kg_) { base.init(M, N, G_, c_); kg = kg_; }
    __host__ __device__ bool next(int j, Unit& u) const { if (!base.next(j >> 3, u)) return false; u.g = j & 7; return true; }
    __host__ __device__ bool tile_next(int i, Unit& u) const { return base.next(i, u); }
    __device__ __forceinline__ size_t aoff(const Unit& u, int lda) const { return ((size_t)u.pm * BM * lda + (size_t)u.g * kg) * 2; }
    __device__ __forceinline__ size_t boff(const Unit& u, int ldb) const { return ((size_t)u.pn * BM * ldb + (size_t)u.g * kg) * 2; }
    __device__ __forceinline__ void a_ready(const Unit&) const {}
    __device__ __forceinline__ void done(const Unit&) const {}
};
struct KSplitOrder {
    int nM, G, c, pn0, kslice;
    __host__ __device__ void init(int M, int G_, int c_, int pn0_, int kslice_) { nM = M / BM; G = G_; c = c_; pn0 = pn0_; kslice = kslice_; }
    __host__ __device__ bool next(int i, Unit& u) const { const long L = (long)i * G + c; if (L >= (long)nM * 4) return false; u.pm = (int)(L >> 2); u.pn = (int)(L & 3); u.g = 0; return true; }
    __device__ __forceinline__ size_t aoff(const Unit& u, int lda) const { return ((size_t)u.pm * BM * lda + (size_t)u.pn * kslice) * 2; }
    __device__ __forceinline__ size_t boff(const Unit& u, int ldb) const { return ((size_t)pn0 * BM * ldb + (size_t)u.pn * kslice) * 2; }
    __device__ __forceinline__ void a_ready(const Unit&) const {}
    __device__ __forceinline__ void done(const Unit&) const {}
};
__device__ __forceinline__ unsigned cvt_pk_bf16(float lo, float hi) { unsigned r; asm volatile("v_cvt_pk_bf16_f32 %0, %1, %2" : "=v"(r) : "v"(lo), "v"(hi)); return r; }
typedef float f32x2 __attribute__((ext_vector_type(2)));
__device__ __forceinline__ float silu_f(float v) { return v * __builtin_amdgcn_rcpf(1.0f + __builtin_amdgcn_exp2f(-1.44269504f * v)); }
__device__ __forceinline__ u32x4 pack8(const f32x4 v0, const f32x4 v1) { u32x4 w; w.x = cvt_pk_bf16(v0[0], v0[1]); w.y = cvt_pk_bf16(v0[2], v0[3]); w.z = cvt_pk_bf16(v1[0], v1[1]); w.w = cvt_pk_bf16(v1[2], v1[3]); return w; }

constexpr int ROWTAB_OFF = STAGE_BYTES + 1024;
__device__ __forceinline__ void rowtab_build(const float* psq, int pm, PG8_LAS unsigned char* lds, int tid) {
    const int row = tid >> 1; const float* p = psq + ((size_t)pm * BM + row) * 64 + (tid & 1) * 32; float sacc = 0.f;
#pragma unroll
    for (int i = 0; i < 8; ++i) { const f32x4 v = *(const f32x4*)(p + 4 * i); sacc += (v[0] + v[1]) + (v[2] + v[3]); }
    sacc += __shfl_xor(sacc, 1);
    if ((tid & 1) == 0) *(PG8_LAS float*)(lds + ROWTAB_OFF + row * 4) = 1.0f / sqrtf(sacc * (1.0f / 4096.0f) + 1e-6f);
}
__device__ __forceinline__ void rowtab_copy(const float* rstd, int pm, PG8_LAS unsigned char* lds, int tid) {
    if (tid < BM) *(PG8_LAS float*)(lds + ROWTAB_OFF + tid * 4) = rstd[(size_t)pm * BM + tid];
}
struct EpiSsdIn {
    static constexpr bool PERM = true, AFTER_DRAIN = false, GROUPED = false, ROWTAB = true;
    bf16_t* Z; bf16_t* XBC; const float* rstd;
    __device__ __forceinline__ void row_table(int pm, PG8_LAS unsigned char* lds, int tid) const { rowtab_copy(rstd, pm, lds, tid); }
    __device__ __forceinline__ void epi(const f32x4 (&acc)[2][2][4][2], const Unit& u, PG8_LAS unsigned char* lds, int wr, int wc, int fr, int fq) const {
        const PG8_LAS float* tab = (const PG8_LAS float*)(lds + ROWTAB_OFF) + wr * 64 + fr;
        const int row0 = u.pm * BM + wr * 64 + fr;
        bf16_t* base; int ldc, colt;
        if (u.pn < 32) { base = Z; ldc = 8192; colt = u.pn * BM; } else { base = XBC; ldc = 10240; colt = (u.pn - 32) * BM; }
        const int col0 = colt + wc * 32 + 8 * fq;
        float rs[2][4];
#pragma unroll
        for (int ai = 0; ai < 2; ++ai)
#pragma unroll
            for (int m = 0; m < 4; ++m) rs[ai][m] = tab[ai * HALF + m * 16];
#pragma unroll
        for (int ai = 0; ai < 2; ++ai)
#pragma unroll
            for (int m = 0; m < 4; ++m) { bf16_t* rowp = base + (size_t)(row0 + ai * HALF + m * 16) * ldc + col0; const float r = rs[ai][m];
#pragma unroll
                for (int bj = 0; bj < 2; ++bj) *(u32x4*)(rowp + bj * HALF) = pack8(acc[ai][bj][m][0] * r, acc[ai][bj][m][1] * r); }
    }
};
struct EpiDtPart {
    static constexpr bool PERM = true, AFTER_DRAIN = false, GROUPED = false, ROWTAB = true;
    float* DTP; const float* rstd;
    __device__ __forceinline__ void row_table(int pm, PG8_LAS unsigned char* lds, int tid) const { rowtab_copy(rstd, pm, lds, tid); }
    __device__ __forceinline__ void epi(const f32x4 (&acc)[2][2][4][2], const Unit& u, PG8_LAS unsigned char* lds, int wr, int wc, int fr, int fq) const {
        const PG8_LAS float* tab = (const PG8_LAS float*)(lds + ROWTAB_OFF) + wr * 64 + fr;
        const int row0 = u.pm * BM + wr * 64 + fr, col0 = wc * 32 + 8 * fq; float* base = DTP + (size_t)u.pn * 16384 * 128;
        float rs[2][4];
#pragma unroll
        for (int ai = 0; ai < 2; ++ai)
#pragma unroll
            for (int m = 0; m < 4; ++m) rs[ai][m] = tab[ai * HALF + m * 16];
#pragma unroll
        for (int ai = 0; ai < 2; ++ai)
#pragma unroll
            for (int m = 0; m < 4; ++m) { float* rowp = base + (size_t)(row0 + ai * HALF + m * 16) * 128 + col0; const float r = rs[ai][m];
                *(f32x4*)rowp = acc[ai][0][m][0] * r; *(f32x4*)(rowp + 4) = acc[ai][0][m][1] * r; }
    }
};
struct EpiGlaIn {
    static constexpr bool PERM = true, AFTER_DRAIN = false, GROUPED = false, ROWTAB = true;
    bf16_t* PROJ; const float* psq;
    __device__ __forceinline__ void row_table(int pm, PG8_LAS unsigned char* lds, int tid) const { rowtab_build(psq, pm, lds, tid); }
    __device__ __forceinline__ void epi(const f32x4 (&acc)[2][2][4][2], const Unit& u, PG8_LAS unsigned char* lds, int wr, int wc, int fr, int fq) const {
        const PG8_LAS float* tab = (const PG8_LAS float*)(lds + ROWTAB_OFF) + wr * 64 + fr;
        const int row0 = u.pm * BM + wr * 64 + fr, col0 = u.pn * BM + wc * 32 + 8 * fq;
#pragma unroll
        for (int ai = 0; ai < 2; ++ai)
#pragma unroll
            for (int m = 0; m < 4; ++m) { const int row = row0 + ai * HALF + m * 16; const float r = tab[ai * HALF + m * 16]; bf16_t* rowp = PROJ + (size_t)row * 12288 + col0;
#pragma unroll
                for (int bj = 0; bj < 2; ++bj) *(u32x4*)(rowp + bj * HALF) = pack8(acc[ai][bj][m][0] * r, acc[ai][bj][m][1] * r); }
    }
};
struct EpiGkPart {
    static constexpr bool PERM = true, AFTER_DRAIN = false, GROUPED = false, ROWTAB = true;
    float* GKP; const float* psq;
    __device__ __forceinline__ void row_table(int pm, PG8_LAS unsigned char* lds, int tid) const { rowtab_build(psq, pm, lds, tid); }
    __device__ __forceinline__ void epi(const f32x4 (&acc)[2][2][4][2], const Unit& u, PG8_LAS unsigned char* lds, int wr, int wc, int fr, int fq) const {
        const PG8_LAS float* tab = (const PG8_LAS float*)(lds + ROWTAB_OFF) + wr * 64 + fr;
        const int row0 = u.pm * BM + wr * 64 + fr; float* base = GKP + (size_t)u.pn * 16384 * 16;
        if (wc == 0 && fq < 2) {
#pragma unroll
            for (int ai = 0; ai < 2; ++ai)
#pragma unroll
                for (int m = 0; m < 4; ++m) { const int row = row0 + ai * HALF + m * 16; const float r = tab[ai * HALF + m * 16]; float* rowp = base + (size_t)row * 16 + 8 * fq;
                    *(f32x4*)rowp = acc[ai][0][m][0] * r; *(f32x4*)(rowp + 4) = acc[ai][0][m][1] * r; }
        }
    }
};
struct EpiSwiGLU {
    static constexpr bool PERM = true, AFTER_DRAIN = false, GROUPED = false, ROWTAB = true;
    static constexpr int TAB_OFF = ROWTAB_OFF;
    bf16_t* O; int ldc; const float* psq;
    __device__ __forceinline__ void row_table(int pm, PG8_LAS unsigned char* lds, int tid) const { rowtab_build(psq, pm, lds, tid); }
    __device__ __forceinline__ void epi(const f32x4 (&acc)[2][2][4][2], const Unit& u, PG8_LAS unsigned char* lds, int wr, int wc, int fr, int fq) const {
        const PG8_LAS float* tab = (const PG8_LAS float*)(lds + TAB_OFF) + wr * 64 + fr;
        (*this)(acc, u, tab, wr, wc, fr, fq); }
    __device__ __forceinline__ void operator()(const f32x4 (&acc)[2][2][4][2], const Unit& u, const PG8_LAS float* tab, int wr, int wc, int fr, int fq) const {
        const int row0 = u.pm * BM + wr * 64 + fr, col0 = u.pn * HALF + wc * 32 + 8 * fq;
#pragma unroll
        for (int ai = 0; ai < 2; ++ai)
#pragma unroll
            for (int m = 0; m < 4; ++m) { const int row = row0 + ai * HALF + m * 16; const float r = tab[ai * HALF + m * 16]; bf16_t* rowp = O + (size_t)row * ldc + col0;
                const float c1 = -1.44269504f * r, r2 = r * r; const f32x2 c1v = {c1, c1}, r2v = {r2, r2}, one = {1.0f, 1.0f};
                f32x4 v[2];
#pragma unroll
                for (int n = 0; n < 2; ++n)
#pragma unroll
                    for (int h = 0; h < 2; ++h) { const f32x2 g = {acc[ai][0][m][n][2 * h], acc[ai][0][m][n][2 * h + 1]}, uu = {acc[ai][1][m][n][2 * h], acc[ai][1][m][n][2 * h + 1]};
                        const f32x2 t = g * c1v; const f32x2 d = (f32x2){__builtin_amdgcn_exp2f(t.x), __builtin_amdgcn_exp2f(t.y)} + one;
                        const f32x2 q = {__builtin_amdgcn_rcpf(d.x), __builtin_amdgcn_rcpf(d.y)};
                        const f32x2 o = ((g * uu) * r2v) * q; v[n][2 * h] = o.x; v[n][2 * h + 1] = o.y; }
                *(u32x4*)rowp = pack8(v[0], v[1]); }
    }
};
template <bool BASE_F32, bool GROUPED_> struct EpiResBf16 {
    static constexpr bool PERM = true, AFTER_DRAIN = false, GROUPED = GROUPED_, ROWTAB = false;
    const void* base; bf16_t* out; float* psq; const float* ssq; float inv_n;
    static constexpr int TAB_OFF = STAGE_BYTES + 1024;
    __device__ __forceinline__ void tile_begin(const Unit& u, PG8_LAS unsigned char* lds, int par, int tid) const {
        int t_ = tid; asm volatile("" : "+v"(t_));
        const float* p = ssq + ((size_t)u.pm * BM + (t_ >> 1)) * 128 + (t_ & 1) * 64; float sg[4];
#pragma unroll
        for (int k = 0; k < 4; ++k) { const f32x4 a = *(const f32x4*)(p + 16 * k), b = *(const f32x4*)(p + 16 * k + 4), c = *(const f32x4*)(p + 16 * k + 8), d = *(const f32x4*)(p + 16 * k + 12); const f32x4 t = (a + b) + (c + d);
            sg[k] = 1.0f / sqrtf(((t[0] + t[1]) + (t[2] + t[3])) * inv_n + 1e-5f); }
        const float s4 = __shfl_xor(sg[0], 1);
        const f32x4 r = {sg[0] / sg[1], sg[1] / sg[2], sg[2] / sg[3], (t_ & 1) ? sg[3] : sg[3] / s4};
        *(PG8_LAS f32x4*)(lds + TAB_OFF + par * 8192 + t_ * 16) = r;
    }
    __device__ __forceinline__ void rescale(f32x4 (&acc)[2][2][4][2], PG8_LAS unsigned char* lds, int par, int g, int wr, int fr) const {
        int rb = wr * 64 + fr; asm volatile("" : "+v"(rb));
        const PG8_LAS float* q = (const PG8_LAS float*)(lds + TAB_OFF + par * 8192) + rb * 8 + g;
#pragma unroll
        for (int ai = 0; ai < 2; ++ai)
#pragma unroll
            for (int m = 0; m < 4; ++m) { const float f = (g == 7) ? 0.f : q[(ai * HALF + m * 16) * 8];
#pragma unroll
                for (int bj = 0; bj < 2; ++bj)
#pragma unroll
                    for (int n = 0; n < 2; ++n) acc[ai][bj][m][n] = acc[ai][bj][m][n] * f; }
    }
    __device__ __forceinline__ void operator()(const f32x4 (&acc)[2][2][4][2], const Unit& u, int wr, int wc, int fr, int fq) const { store(acc, u, nullptr, wr, wc, fr, fq); }
    __device__ __forceinline__ void epi_g(const f32x4 (&acc)[2][2][4][2], const Unit& u, PG8_LAS unsigned char* lds, int par, int wr, int wc, int fr, int fq) const {
        store(acc, u, (const PG8_LAS float*)(lds + TAB_OFF + par * 8192) + (wr * 64 + fr) * 8 + 7, wr, wc, fr, fq); }
    __device__ __forceinline__ void store(const f32x4 (&acc)[2][2][4][2], const Unit& u, const PG8_LAS float* q7, int wr, int wc, int fr, int fq) const {
        const int row0 = u.pm * BM + wr * 64 + fr, col0 = u.pn * BM + wc * 32 + 8 * fq;
        constexpr int NB = BASE_F32 ? 2 : 4;
#pragma unroll
        for (int ai = 0; ai < 2; ++ai)
#pragma unroll
            for (int mb = 0; mb < 4; mb += NB) {
                f32x4 bf[NB][2][2]; u32x4 bw[NB][2]; float sc[NB];
#pragma unroll
                for (int i = 0; i < NB; ++i) { const int row = row0 + ai * HALF + (mb + i) * 16; const size_t off = (size_t)row * 4096 + col0;
                    sc[i] = GROUPED ? q7[(ai * HALF + (mb + i) * 16) * 8] : 1.0f;
#pragma unroll
                    for (int bj = 0; bj < 2; ++bj) {
                        if (BASE_F32) { bf[i][bj][0] = *(const f32x4*)((const float*)base + off + bj * HALF); bf[i][bj][1] = *(const f32x4*)((const float*)base + off + bj * HALF + 4); }
                        else bw[i][bj] = *(const u32x4*)((const bf16_t*)base + off + bj * HALF); } }
                if (GROUPED) asm volatile("" ::: "memory");
#pragma unroll
                for (int i = 0; i < NB; ++i) { const int m = mb + i; const int row = row0 + ai * HALF + m * 16; const size_t off = (size_t)row * 4096 + col0; f32x2 ssq2 = {0.f, 0.f};
#pragma unroll
                    for (int bj = 0; bj < 2; ++bj) { f32x4 b0, b1;
                        if (BASE_F32) { b0 = bf[i][bj][0]; b1 = bf[i][bj][1]; }
                        else { const u32x4 w = bw[i][bj];
                            b0 = (f32x4){__builtin_bit_cast(float, w.x << 16), __builtin_bit_cast(float, w.x & 0xffff0000u), __builtin_bit_cast(float, w.y << 16), __builtin_bit_cast(float, w.y & 0xffff0000u)};
                            b1 = (f32x4){__builtin_bit_cast(float, w.z << 16), __builtin_bit_cast(float, w.z & 0xffff0000u), __builtin_bit_cast(float, w.w << 16), __builtin_bit_cast(float, w.w & 0xffff0000u)}; }
                        const f32x4 v0 = GROUPED ? b0 + acc[ai][bj][m][0] * sc[i] : b0 + acc[ai][bj][m][0], v1 = GROUPED ? b1 + acc[ai][bj][m][1] * sc[i] : b1 + acc[ai][bj][m][1];
                        { const f32x2 p0 = {v0[0], v0[1]}, p1 = {v0[2], v0[3]}, p2 = {v1[0], v1[1]}, p3 = {v1[2], v1[3]}; ssq2 = ssq2 + p0 * p0; ssq2 = ssq2 + p1 * p1; ssq2 = ssq2 + p2 * p2; ssq2 = ssq2 + p3 * p3; }
                        *(u32x4*)(out + off + bj * HALF) = pack8(v0, v1); }
                    float ssq_ = ssq2.x + ssq2.y; ssq_ += __shfl_xor(ssq_, 16); ssq_ += __shfl_xor(ssq_, 32);
                    if (fq == 0) psq[(size_t)row * 64 + u.pn * 4 + wc] = ssq_; }
                if (GROUPED) asm volatile("" ::: "memory"); }
    }
};
template <class Epi, class Sched, bool ALIGN_EPI = false, bool SP2 = false>
__device__ __forceinline__ void gemm_phase(PG8_LAS unsigned char* lds, const Gemm g, const Sched& S, const Epi& E) {
    const int tid = threadIdx.x, wid = __builtin_amdgcn_readfirstlane(tid >> 6), lane = tid & 63, wr = wid >> 2, wc = wid & 3, fr = lane & 15, fq = lane >> 4;
    const int K = g.K, nt = K / BK, lda = g.lda, ldb = g.ldb;
    unsigned voffA[2], voffB[2];
#pragma unroll
    for (int i = 0; i < 2; ++i) { int R, C; stage_rc(tid * 16 + i * 8192, R, C); const int Rb = Epi::PERM ? ((R & ~31) + perm32(R & 31)) : R;
        voffA[i] = (unsigned)(R * lda + C) * 2u; voffB[i] = (unsigned)(Rb * ldb + C) * 2u; }
    const size_t kstep = (size_t)(BK * 2);
    const size_t hstepA = (size_t)HALF * lda * 2, hstepB = (size_t)HALF * ldb * 2;
    const unsigned ldsw = (unsigned)wid * 1024u;
    const int aoff = lds_byte(wr * 64 + fr, fq * 8), boff = lds_byte(wc * 32 + fr, fq * 8);
#define PG8_SA(b, h) (((b) * 2 + (h)) * HTB)
#define PG8_SB(b, h) ((4 + (b) * 2 + (h)) * HTB)
#define PG8_STAGE(bufoff, gbase, voff) do { _Pragma("unroll") for (int _i = 0; _i < 2; ++_i) \
        __builtin_amdgcn_global_load_lds((const unsigned*)((const char*)(gbase) + (voff)[_i]), (PG8_LAS unsigned*)(lds + (bufoff) + ldsw + _i * 8192), 16, 0, 0); } while (0)
#define PG8_LDA(dst, b, h) do { _Pragma("unroll") for (int m = 0; m < 4; ++m) _Pragma("unroll") for (int k = 0; k < 2; ++k) dst[m][k] = *(const PG8_LAS bf16x8*)(lds + PG8_SA(b, h) + aoff + m * 2048 + k * 1024); } while (0)
#define PG8_LDB(dst, b, h) do { _Pragma("unroll") for (int n = 0; n < 2; ++n) _Pragma("unroll") for (int k = 0; k < 2; ++k) dst[n][k] = *(const PG8_LAS bf16x8*)(lds + PG8_SB(b, h) + boff + n * 2048 + k * 1024); } while (0)
#ifndef PG8_PRIO_MODE
#define PG8_PRIO_MODE 1
#endif
#if PG8_PRIO_MODE == 1
#define PG8_PRIO_ON __builtin_amdgcn_s_setprio(1)
#define PG8_PRIO_OFF __builtin_amdgcn_s_setprio(0)
#else
#define PG8_PRIO_ON
#define PG8_PRIO_OFF
#endif
#define PG8_MMA(ai, bj, At, Bt) do { PG8_PRIO_ON; _Pragma("unroll") for (int m = 0; m < 4; ++m) _Pragma("unroll") for (int n = 0; n < 2; ++n) _Pragma("unroll") for (int k = 0; k < 2; ++k) \
        acc[ai][bj][m][n] = __builtin_amdgcn_mfma_f32_16x16x32_bf16(Bt[n][k], At[m][k], acc[ai][bj][m][n], 0, 0, 0); PG8_PRIO_OFF; } while (0)
#define PG8_WAIT_V(n) asm volatile("s_waitcnt vmcnt(" #n ")" ::: "memory")
#define PG8_WAIT_L(n) asm volatile("s_waitcnt lgkmcnt(" #n ")" ::: "memory")
#define PG8_BAR __builtin_amdgcn_s_barrier()
#define PG8_SCHED __builtin_amdgcn_sched_barrier(0)
    Unit cur, nxt, tnext; int ui = 0, tpar = 0; bool tnext_ok = false; tnext.pm = 0; tnext.pn = 0; tnext.g = 0;
    if (!S.next(0, cur)) return;
    f32x4 acc[2][2][4][2];
#pragma unroll
    for (int a = 0; a < 2; ++a)
#pragma unroll
        for (int b = 0; b < 2; ++b)
#pragma unroll
            for (int m = 0; m < 4; ++m)
#pragma unroll
                for (int n = 0; n < 2; ++n) acc[a][b][m][n] = (f32x4){0.f, 0.f, 0.f, 0.f};
    bf16x8 At[4][2], B0[2][2], B1[2][2];
    const char* cA = (const char*)g.A + S.aoff(cur, lda); const char* cB = (const char*)g.Bt + S.boff(cur, ldb);
    S.a_ready(cur);
    if constexpr (Epi::GROUPED) E.tile_begin(cur, lds, 0, tid);
    if constexpr (SP2) {
        PG8_STAGE(PG8_SB(0, 0), cB, voffB); PG8_STAGE(PG8_SB(0, 1), cB + hstepB, voffB); PG8_STAGE(PG8_SA(0, 0), cA, voffA); PG8_STAGE(PG8_SA(0, 1), cA + hstepA, voffA);
        if (wr == 1) PG8_BAR;
        PG8_WAIT_V(2); PG8_BAR;
        PG8_STAGE(PG8_SB(1, 0), cB + kstep, voffB); PG8_STAGE(PG8_SA(1, 0), cA + kstep, voffA); PG8_STAGE(PG8_SB(1, 1), cB + hstepB + kstep, voffB);
        PG8_WAIT_V(6); PG8_BAR;
    } else {
        PG8_STAGE(PG8_SB(0, 0), cB, voffB); PG8_STAGE(PG8_SA(0, 0), cA, voffA); PG8_STAGE(PG8_SB(0, 1), cB + hstepB, voffB); PG8_STAGE(PG8_SA(0, 1), cA + hstepA, voffA);
        if (wr == 1) PG8_BAR;
        PG8_WAIT_V(4); PG8_BAR;
        PG8_STAGE(PG8_SB(1, 0), cB + kstep, voffB); PG8_STAGE(PG8_SA(1, 0), cA + kstep, voffA); PG8_STAGE(PG8_SB(1, 1), cB + hstepB + kstep, voffB);
        PG8_WAIT_V(6); PG8_BAR;
    }
    if constexpr (Epi::ROWTAB) E.row_table(cur.pm, lds, tid);
    for (;;) {
        bool has_next;
        if constexpr (Epi::GROUPED) {
            if (cur.g == 0) tnext_ok = S.tile_next((ui >> 3) + 1, tnext);
            if (cur.g < 7) { nxt = cur; nxt.g = cur.g + 1; has_next = true; } else { nxt = tnext; has_next = tnext_ok; }
        } else has_next = S.next(ui + 1, nxt);
        const char* nA = has_next ? (const char*)g.A + S.aoff(nxt, lda) : cA; const char* nB = has_next ? (const char*)g.Bt + S.boff(nxt, ldb) : cB;
        for (int t = 0; t < nt; t += 2) {
            const bool last = (t == nt - 2);
            const char* a1 = cA + (size_t)(t + 1) * kstep;
            const char* a2 = last ? nA : cA + (size_t)(t + 2) * kstep; const char* b2 = last ? nB : cB + (size_t)(t + 2) * kstep;
            const char* a3 = a2 + kstep; const char* b3 = b2 + kstep;
            if (last && has_next) S.a_ready(nxt);
            if constexpr (SP2) {
            PG8_LDB(B0, 0, 0); PG8_LDB(B1, 0, 1); PG8_SCHED; PG8_LDA(At, 0, 0); PG8_STAGE(PG8_SA(1, 1), a1 + hstepA, voffA);
            PG8_WAIT_V(8); PG8_WAIT_L(0); PG8_BAR; PG8_MMA(0, 0, At, B0); PG8_MMA(0, 1, At, B1); PG8_BAR; PG8_SCHED;
            PG8_LDA(At, 0, 1); PG8_STAGE(PG8_SB(0, 0), b2, voffB); PG8_STAGE(PG8_SB(0, 1), b2 + hstepB, voffB); PG8_STAGE(PG8_SA(0, 0), a2, voffA);
            PG8_WAIT_V(8); PG8_WAIT_L(0); PG8_BAR; PG8_MMA(1, 0, At, B0); PG8_MMA(1, 1, At, B1); PG8_BAR; PG8_SCHED;
            PG8_LDB(B0, 1, 0); PG8_LDB(B1, 1, 1); PG8_SCHED; PG8_LDA(At, 1, 0); PG8_STAGE(PG8_SA(0, 1), a2 + hstepA, voffA);
            PG8_WAIT_V(8); PG8_WAIT_L(0); PG8_BAR; PG8_MMA(0, 0, At, B0); PG8_MMA(0, 1, At, B1); PG8_BAR; PG8_SCHED;
            PG8_LDA(At, 1, 1); PG8_STAGE(PG8_SB(1, 0), b3, voffB); PG8_STAGE(PG8_SB(1, 1), b3 + hstepB, voffB); PG8_STAGE(PG8_SA(1, 0), a3, voffA);
            PG8_WAIT_V(8); PG8_WAIT_L(0); PG8_BAR; PG8_MMA(1, 0, At, B0); PG8_MMA(1, 1, At, B1); PG8_BAR; PG8_SCHED;
            } else {
            PG8_LDB(B0, 0, 0); PG8_SCHED; PG8_LDA(At, 0, 0); PG8_STAGE(PG8_SA(1, 1), a1 + hstepA, voffA);
            PG8_WAIT_L(8); PG8_BAR; PG8_WAIT_L(0); PG8_MMA(0, 0, At, B0); PG8_BAR; PG8_SCHED;
            PG8_LDB(B1, 0, 1); PG8_STAGE(PG8_SB(0, 0), b2, voffB);
            PG8_BAR; PG8_WAIT_L(0); PG8_MMA(0, 1, At, B1); PG8_BAR;
            PG8_LDA(At, 0, 1); PG8_STAGE(PG8_SA(0, 0), a2, voffA);
            PG8_BAR; PG8_WAIT_L(0); PG8_MMA(1, 0, At, B0); PG8_BAR; PG8_SCHED;
            PG8_STAGE(PG8_SB(0, 1), b2 + hstepB, voffB);
            PG8_WAIT_V(6); PG8_BAR; PG8_MMA(1, 1, At, B1); PG8_BAR;
            PG8_LDB(B0, 1, 0); PG8_SCHED; PG8_LDA(At, 1, 0); PG8_STAGE(PG8_SA(0, 1), a2 + hstepA, voffA);
            PG8_WAIT_L(8); PG8_BAR; PG8_WAIT_L(0); PG8_MMA(0, 0, At, B0); PG8_BAR; PG8_SCHED;
            PG8_LDB(B1, 1, 1); PG8_STAGE(PG8_SB(1, 0), b3, voffB);
            PG8_BAR; PG8_WAIT_L(0); PG8_MMA(0, 1, At, B1); PG8_BAR;
            PG8_LDA(At, 1, 1); PG8_STAGE(PG8_SA(1, 0), a3, voffA);
            PG8_BAR; PG8_WAIT_L(0); PG8_MMA(1, 0, At, B0); PG8_BAR; PG8_SCHED;
            PG8_STAGE(PG8_SB(1, 1), b3 + hstepB, voffB);
            PG8_WAIT_V(6); PG8_BAR; PG8_MMA(1, 1, At, B1); PG8_BAR;
            }
        }
        const bool fin = !Epi::GROUPED || cur.g == 7;
        if constexpr (ALIGN_EPI) { if (wr == 0 && fin) PG8_BAR; }
        if constexpr (Epi::GROUPED) {
            if (cur.g == 7) E.epi_g(acc, cur, lds, tpar, wr, wc, fr, fq);
            E.rescale(acc, lds, tpar, cur.g, wr, fr);
            if (cur.g == 7 && has_next && nxt.pm != cur.pm) { E.tile_begin(nxt, lds, tpar ^ 1, tid); tpar ^= 1; }
            S.done(cur); }
        else if constexpr (Epi::ROWTAB) { E.epi(acc, cur, lds, wr, wc, fr, fq); S.done(cur);
            if (has_next && nxt.pm != cur.pm) { PG8_BAR; E.row_table(nxt.pm, lds, tid); PG8_WAIT_L(0); PG8_BAR; } }
        else if constexpr (!Epi::AFTER_DRAIN) { E(acc, cur, wr, wc, fr, fq); S.done(cur); }
        if (!has_next) break;
        if constexpr (!Epi::GROUPED) {
#pragma unroll
        for (int a = 0; a < 2; ++a)
#pragma unroll
            for (int b = 0; b < 2; ++b)
#pragma unroll
                for (int m = 0; m < 4; ++m)
#pragma unroll
                    for (int n = 0; n < 2; ++n) acc[a][b][m][n] = (f32x4){0.f, 0.f, 0.f, 0.f};
        }
        cur = nxt; cA = nA; cB = nB; ++ui;
        if constexpr (ALIGN_EPI) { if (wr == 1 && fin) PG8_BAR; }
    }
    PG8_WAIT_V(0);
    if constexpr (!ALIGN_EPI) { if (wr == 0) PG8_BAR; }
    PG8_BAR;
    if constexpr (Epi::AFTER_DRAIN) { E.fused(acc, cur, wr, wc, fr, fq, lds, wid, lane); S.done(cur); }
#undef PG8_SA
#undef PG8_SB
#undef PG8_STAGE
#undef PG8_LDA
#undef PG8_LDB
#undef PG8_MMA
#undef PG8_WAIT_V
#undef PG8_WAIT_L
#undef PG8_BAR
#undef PG8_SCHED
}
}
#define GAS __attribute__((address_space(1)))
#define LAS __attribute__((address_space(3)))
typedef unsigned short bf16;
typedef unsigned v4u __attribute__((ext_vector_type(4)));
typedef float f32x4 __attribute__((ext_vector_type(4)));
typedef short bf16x8 __attribute__((ext_vector_type(8)));
typedef GAS unsigned gu32;
typedef GAS unsigned long long gu64;
#define RLX_AGENT __ATOMIC_RELAXED, __HIP_MEMORY_SCOPE_AGENT
#define LDS_WAIT() asm volatile("s_waitcnt lgkmcnt(0)" ::: "memory")
#define VM_WAIT() asm volatile("s_waitcnt vmcnt(0)" ::: "memory")
__device__ __forceinline__ unsigned long long rt() { return __builtin_amdgcn_s_memrealtime(); }
__device__ __forceinline__ unsigned f2bf(float f) { unsigned u = __builtin_bit_cast(unsigned, f); return (u + 0x7fffu + ((u >> 16) & 1u)) >> 16; }
typedef __bf16 bf16n2 __attribute__((ext_vector_type(2)));
__device__ __forceinline__ unsigned pk2(float lo, float hi) { const bf16n2 v = {(__bf16)lo, (__bf16)hi}; return __builtin_bit_cast(unsigned, v); }

#define XB_TMO      128
#define XB_XCNT(j)  (256  + 64 * (j))
#define XB_XSUB(j)  (1280 + 64 * (j))
#define XB_XGEN(j)  (2304 + 64 * (j))
#define XB_TOP      3328
#define XB_TOPGEN   3392
#define XCD_BAR_WORDS 3456
#define XB_SPIN_CAP (1u << 18)

__device__ __forceinline__ unsigned xb_ld(unsigned* p)              { return __hip_atomic_load(p, __ATOMIC_RELAXED, __HIP_MEMORY_SCOPE_AGENT); }
__device__ __forceinline__ unsigned xb_add(unsigned* p, unsigned v) { return __hip_atomic_fetch_add(p, v, __ATOMIC_RELAXED, __HIP_MEMORY_SCOPE_AGENT); }
__device__ __forceinline__ unsigned xb_xcc_id() { return (unsigned)__builtin_amdgcn_s_getreg((3 << 11) | 20) & 0xFu; }
#define XB_SPIN(cond, bar) do { unsigned _sp = 0; while (cond) { __builtin_amdgcn_s_sleep(1); \
    if ((++_sp & 255u) == 0u) { if (xb_ld(&(bar)[XB_TMO])) break; if (_sp > XB_SPIN_CAP) { atomicAdd(&(bar)[XB_TMO], 1u); break; } } } } while (0)

struct XcdBarrier {
    unsigned* bar; unsigned x;
    volatile LAS unsigned* st;
};

__device__ __forceinline__ XcdBarrier xcd_barrier_post(unsigned* bar, volatile LAS unsigned* st) {
    XcdBarrier b; b.bar = bar; b.x = xb_xcc_id(); b.st = st;
    if (threadIdx.x == 0) (void)xb_add(&bar[XB_XCNT(b.x)], 1u);
    return b;
}
__device__ __forceinline__ void xcd_barrier_complete(unsigned* bar, unsigned x, unsigned& nloc, unsigned& nx) {
    const unsigned G = gridDim.x * gridDim.y * gridDim.z;
    unsigned sum, cnt, mine, sp = 0u;
    for (;;) {
        sum = 0u; cnt = 0u; mine = 0u;
#pragma unroll
        for (unsigned j = 0; j < 16; ++j) { const unsigned c = xb_ld(&bar[XB_XCNT(j)]); sum += c; cnt += (c > 0u) ? 1u : 0u; mine = (j == x) ? c : mine; }
        if (sum == G) break;
        __builtin_amdgcn_s_sleep(1);
        if ((++sp & 255u) == 0u) { if (xb_ld(&bar[XB_TMO])) break; if (sp > XB_SPIN_CAP) { atomicAdd(&bar[XB_TMO], 1u); break; } }
    }
    nloc = mine > 0u ? mine : 1u; nx = cnt > 0u ? cnt : 1u;
}

__device__ __forceinline__ void xcd_barrier(const XcdBarrier& b) {
    asm volatile("s_waitcnt vmcnt(0)" ::: "memory");
    __syncthreads();
    if (threadIdx.x == 0) {
        unsigned* bar = b.bar;
        __builtin_amdgcn_s_waitcnt(0);
        unsigned nloc = b.st[0], nx = b.st[1];
        if (nloc == 0u) { xcd_barrier_complete(bar, b.x, nloc, nx); b.st[0] = nloc; b.st[1] = nx; }
        const unsigned old = xb_add(&bar[XB_XSUB(b.x)], 1u);
        const unsigned gen = old / nloc;
        if (old + 1u == (gen + 1u) * nloc) {
            __builtin_amdgcn_fence(__ATOMIC_RELEASE, "agent");
            asm volatile("s_waitcnt vmcnt(0)" ::: "memory");
            const unsigned og = xb_add(&bar[XB_TOP], 1u);
            const unsigned tg = og / nx;
            if (og + 1u == (tg + 1u) * nx) xb_add(&bar[XB_TOPGEN], 1u);
            else XB_SPIN(xb_ld(&bar[XB_TOPGEN]) == tg, bar);
            __builtin_amdgcn_fence(__ATOMIC_ACQUIRE, "agent");
            xb_add(&bar[XB_XGEN(b.x)], 1u);
            asm volatile("s_waitcnt vmcnt(0)" ::: "memory");
        } else {
            XB_SPIN(xb_ld(&bar[XB_XGEN(b.x)]) == gen, bar);
            __builtin_amdgcn_fence(__ATOMIC_ACQUIRE, "agent");
            asm volatile("s_waitcnt vmcnt(0)" ::: "memory");
        }
    }
    __syncthreads();
}
typedef float f32x2 __attribute__((ext_vector_type(2)));
constexpr int NWAVES = 8;
#ifndef MK_SPLIT
#define MK_SPLIT 0
#endif
constexpr int NPHASE = 19;

constexpr int M = 16384, T = 8192, D = 4096, DFF = 11008, GU_N = 2 * DFF;
constexpr int S_DI = 8192, S_CONV = 10240, S_IN = 18560, S_INP = 18688;
constexpr int G_PROJ = 12288, G_IN = 12304, G_INP = 12544;
constexpr float NORM_EPS = 1e-6f, INNER_EPS = 1e-5f;

constexpr size_t MiB = 1u << 20;
constexpr size_t WS_CTL = 0, CTL_ZERO_BYTES = 1 * MiB;
constexpr size_t WS_WIN = 2 * MiB;
constexpr size_t WS_WOUT0 = 148 * MiB;
constexpr size_t WS_WOUT1 = 100 * MiB;
constexpr size_t WS_WGU = 212 * MiB;
constexpr size_t WS_WDN = 384 * MiB;
constexpr size_t WS_XN = 470 * MiB;
constexpr size_t WS_R = 598 * MiB;
constexpr size_t WS_Z = WS_R, WS_XBC = WS_R + 256 * MiB, WS_XBC2 = WS_XBC + 320 * MiB, WS_DT = WS_XBC2 + 320 * MiB, WS_SSQ = WS_DT + 8 * MiB, WS_YG = WS_XBC;
constexpr size_t WS_ACT = WS_R;
constexpr size_t WS_PROJ = WS_R, WS_GKL = WS_R + 384 * MiB, WS_EE = WS_GKL + 1 * MiB, WS_QD = WS_GKL + 3 * MiB, WS_KI = WS_QD + 64 * MiB, WS_O = WS_KI + 64 * MiB, WS_SSQ2 = WS_O + 128 * MiB, WS_PB = WS_SSQ2 + 8 * MiB;
constexpr size_t WS_PSQ = 1510 * MiB, WS_RSTD = 1514 * MiB, WS_RAT = 1515 * MiB;
constexpr size_t WS2_WIN = 1516 * MiB, WS2_WOUT = WS2_WIN + 98 * MiB, WS2_WGU = WS2_WOUT + 32 * MiB, WS2_WDN = WS2_WGU + 172 * MiB;
constexpr size_t WS_DTP = WS2_WDN + 86 * MiB, WS_GKP = WS_DTP + 32 * MiB;
constexpr size_t WS_DUMMY = WS_GKP + 4 * MiB;
constexpr size_t WS_END = WS_DUMMY + 1 * MiB;
static_assert(WS_SSQ + 8 * MiB <= WS_END && WS_SSQ2 + 8 * MiB <= WS_END && WS_WIN + (size_t)S_INP * D * 2 <= WS_WOUT0 && WS_WOUT0 + (size_t)D * S_DI * 2 <= WS_WGU && WS_WGU + (size_t)GU_N * D * 2 <= WS_WDN && WS_WDN + (size_t)D * DFF * 2 <= WS_XN, "d_ws map");
static_assert(WS_WIN + (size_t)G_INP * D * 2 <= WS_WOUT1 && WS_WOUT1 + (size_t)D * D * 2 <= WS_WGU && WS_ACT + (size_t)M * DFF * 2 <= WS_O, "d_ws map 2");
constexpr int CW_BAR = 4096;

constexpr int RING_OFF = 0, RING_BYTES = 131072;
constexpr int LDSCTL_OFF = RING_BYTES, MISC_OFF = LDSCTL_OFF + 320;
constexpr int LDS_BYTES = 151552;

__device__ __forceinline__ float wave_sum(float v) {
#pragma unroll
    for (int o = 1; o < 64; o <<= 1) v += __shfl_xor(v, o);
    return v;
}
template <int CTRL> __device__ __forceinline__ float dpp_add(float v) { return v + __builtin_bit_cast(float, __builtin_amdgcn_update_dpp(0, __builtin_bit_cast(int, v), CTRL, 0xF, 0xF, true)); }
template <int CTRL, int ROWMASK> __device__ __forceinline__ float dpp_add_rm(float v) { return v + __builtin_bit_cast(float, __builtin_amdgcn_update_dpp(0, __builtin_bit_cast(int, v), CTRL, ROWMASK, 0xF, false)); }
__device__ __forceinline__ float wave_scan_incl(float v) {
    v = dpp_add<0x111>(v); v = dpp_add<0x112>(v); v = dpp_add<0x114>(v); v = dpp_add<0x118>(v);
    v = dpp_add_rm<0x142, 0xA>(v); v = dpp_add_rm<0x143, 0xC>(v); return v;
}
__device__ __forceinline__ float red4(float v) { v = dpp_add<0xB1>(v); v = dpp_add<0x4E>(v); return v; }
__device__ __forceinline__ float red8(float v) { v = red4(v); return dpp_add<0x141>(v); }
__device__ __forceinline__ float red16(float v) { v = red8(v); return dpp_add<0x140>(v); }
__device__ __forceinline__ float red32(float v) { v = red16(v); return v + __shfl_xor(v, 16); }
__device__ __forceinline__ void bf8_to_f32(const v4u u, float (&f)[8]) {
    f[0] = __builtin_bit_cast(float, u.x << 16); f[1] = __builtin_bit_cast(float, u.x & 0xffff0000u); f[2] = __builtin_bit_cast(float, u.y << 16); f[3] = __builtin_bit_cast(float, u.y & 0xffff0000u);
    f[4] = __builtin_bit_cast(float, u.z << 16); f[5] = __builtin_bit_cast(float, u.z & 0xffff0000u); f[6] = __builtin_bit_cast(float, u.w << 16); f[7] = __builtin_bit_cast(float, u.w & 0xffff0000u);
}
__device__ __forceinline__ float fexp(float x) { return __builtin_amdgcn_exp2f(x * 1.44269504f); }
__device__ __forceinline__ float silu(float v) { return v * __builtin_amdgcn_rcpf(1.0f + fexp(-v)); }
__device__ __forceinline__ float softplus(float x) { return fmaxf(x, 0.f) + log1pf(expf(-fabsf(x))); }

typedef short s16x4 __attribute__((ext_vector_type(4)));
typedef short v4i16_t __attribute__((ext_vector_type(4)));
typedef unsigned v2u __attribute__((ext_vector_type(2)));
__device__ __forceinline__ s16x4 lds_tr4(const LAS bf16* p) { return __builtin_bit_cast(s16x4, __builtin_amdgcn_ds_read_tr16_b64_v4i16((LAS v4i16_t*)p)); }
__device__ __forceinline__ bf16x8 frag_tr(const LAS bf16* T, int stride, int row0, int col0, int lane) {
    const LAS bf16* a = T + (row0 + 8 * (lane >> 4) + ((lane & 15) >> 2)) * stride + col0 + 4 * (lane & 3);
    const s16x4 lo = lds_tr4(a), hi = lds_tr4(a + 4 * stride);
    return (bf16x8){lo[0], lo[1], lo[2], lo[3], hi[0], hi[1], hi[2], hi[3]};
}
__device__ __forceinline__ bf16x8 frag_row(const LAS bf16* T, int stride, int row0, int k0, int lane) { return *(const LAS bf16x8*)(T + (row0 + (lane & 15)) * stride + k0 + 8 * (lane >> 4)); }
#define MFMA16(a, b, c) __builtin_amdgcn_mfma_f32_16x16x32_bf16(a, b, c, 0, 0, 0)

__device__ __forceinline__ void transpose_item(const float* W, int N, int K, bf16* WT, int k0, int n0, int ncols, int drow0, const float* gain, int gmask, LAS bf16* scr, int lane) {
    const int c4 = (lane & 15) * 4, kr = lane >> 4; const bool ok = c4 < ncols;
    f32x4 v[16];
#pragma unroll
    for (int i = 0; i < 16; ++i) v[i] = ok ? __builtin_nontemporal_load((const f32x4*)(W + (size_t)(k0 + 4 * i + kr) * N + n0 + c4)) : (f32x4){0.f, 0.f, 0.f, 0.f};
    if (gain) {
#pragma unroll
        for (int i = 0; i < 16; ++i) v[i] = v[i] * gain[(k0 + 4 * i + kr) & gmask];
    }
#pragma unroll
    for (int i = 0; i < 16; ++i) *(LAS v2u*)(scr + (4 * i + kr) * 72 + c4) = (v2u){pk2(v[i].x, v[i].y), pk2(v[i].z, v[i].w)};
    LDS_WAIT(); asm volatile("" ::: "memory");
#pragma unroll
    for (int rb = 0; rb < 2; ++rb)
#pragma unroll
        for (int cb = 0; cb < 4; ++cb) { const bf16x8 f = frag_tr(scr, 72, 32 * rb, 16 * cb, lane); const int n = 16 * cb + (lane & 15);
            if (n < ncols) *(bf16x8*)(WT + (size_t)(drow0 + n) * K + k0 + 32 * rb + 8 * (lane >> 4)) = f; }
    LDS_WAIT(); asm volatile("" ::: "memory");
}
struct WJob { const float* W; bf16* WT; int K, N, mode; const float* gain; int gmask; };
__device__ __forceinline__ int wjob_items(const WJob& j) { return (j.K / 64) * ((j.N + 63) / 64); }
__device__ __forceinline__ void wjob_item(const WJob& j, int r, LAS bf16* scr, int lane) {
    const int nblk = (j.N + 63) / 64, kb = r / nblk, nb = r - kb * nblk, n0 = 64 * nb, rem = j.N - n0, ncols = rem < 64 ? rem : 64;
    const int drow0 = j.mode == 0 ? n0 : ((n0 >> 7) * 256 + (n0 & 127) + (j.mode == 2 ? 128 : 0));
    transpose_item(j.W, j.N, j.K, j.WT, 64 * kb, n0, ncols, drow0, j.gain, j.gmask, scr, lane);
}
__device__ __forceinline__ void convert_layer(const WJob& j0, const WJob& j1, const WJob& j2, const WJob& j3, const WJob& j4, LAS bf16* scr, int widx, int nw, int lane, int lo = 0, int hi = -1) {
    const int i0 = wjob_items(j0), i1 = wjob_items(j1), i2 = wjob_items(j2), i3 = wjob_items(j3), i4 = wjob_items(j4);
    const int total = (hi < 0) ? (i0 + i1 + i2 + i3 + i4) : hi;
    for (int it = lo + widx; it < total; it += nw) {
        int r = it; WJob j = j0;
        if (r >= i0) { r -= i0; j = j1; if (r >= i1) { r -= i1; j = j2; if (r >= i2) { r -= i2; j = j3; if (r >= i3) { r -= i3; j = j4; } } } }
        wjob_item(j, r, scr, lane);
    }
}
__device__ __forceinline__ void zero_rows_bf16(bf16* p, size_t nelem, int gtid, int nthreads) {
    for (size_t i = (size_t)gtid * 8; i < nelem; i += (size_t)nthreads * 8) *(v4u*)(p + i) = (v4u){0u, 0u, 0u, 0u};
}
__device__ __forceinline__ void rmsnorm_row_bf16(const float* xrow, const float* w, bf16* orow, int lane) {
    const f32x4* xr = (const f32x4*)xrow + lane; f32x4 v[16]; float s = 0.f;
#pragma unroll
    for (int j = 0; j < 16; ++j) { v[j] = xr[64 * j]; s += (v[j].x * v[j].x + v[j].y * v[j].y) + (v[j].z * v[j].z + v[j].w * v[j].w); }
    const float rstd = 1.0f / sqrtf(wave_sum(s) * (1.f / D) + NORM_EPS);
    const f32x4* wr = (const f32x4*)w + lane; unsigned long long* o8 = (unsigned long long*)orow + lane;
#pragma unroll
    for (int j = 0; j < 16; ++j) { const f32x4 ww = wr[64 * j];
        o8[64 * j] = (unsigned long long)pk2(v[j].x * rstd * ww.x, v[j].y * rstd * ww.y) | ((unsigned long long)pk2(v[j].z * rstd * ww.z, v[j].w * rstd * ww.w) << 32); }
}
__device__ __forceinline__ void rmsnorm_row_from_bf16(const bf16* xrow, const float* w, float* orow, int lane) {
    float v[8][8]; float s = 0.f;
#pragma unroll
    for (int j = 0; j < 8; ++j) { bf8_to_f32(*(const v4u*)(xrow + (j * 64 + lane) * 8), v[j]);
#pragma unroll
        for (int e = 0; e < 8; ++e) s += v[j][e] * v[j][e]; }
    const float rstd = 1.0f / sqrtf(wave_sum(s) * (1.f / D) + NORM_EPS);
#pragma unroll
    for (int j = 0; j < 8; ++j) { const int c = (j * 64 + lane) * 8; const f32x4 w0 = *(const f32x4*)(w + c), w1 = *(const f32x4*)(w + c + 4);
        *(f32x4*)(orow + c) = (f32x4){v[j][0] * rstd * w0.x, v[j][1] * rstd * w0.y, v[j][2] * rstd * w0.z, v[j][3] * rstd * w0.w};
        *(f32x4*)(orow + c + 4) = (f32x4){v[j][4] * rstd * w1.x, v[j][5] * rstd * w1.y, v[j][6] * rstd * w1.z, v[j][7] * rstd * w1.w}; }
}
__device__ __forceinline__ void cast_row_rstd(const float* xrow, bf16* orow, float* rstd_out, int lane) {
    const f32x4* xr = (const f32x4*)xrow + lane; f32x4 v[16]; float s = 0.f;
#pragma unroll
    for (int j = 0; j < 16; ++j) { v[j] = xr[64 * j]; s += (v[j].x * v[j].x + v[j].y * v[j].y) + (v[j].z * v[j].z + v[j].w * v[j].w); }
    unsigned long long* o8 = (unsigned long long*)orow + lane;
#pragma unroll
    for (int j = 0; j < 16; ++j) o8[64 * j] = (unsigned long long)pk2(v[j].x, v[j].y) | ((unsigned long long)pk2(v[j].z, v[j].w) << 32);
    s = wave_sum(s); if (lane == 0) *rstd_out = 1.0f / sqrtf(s * (1.f / D) + NORM_EPS);
}
__device__ __forceinline__ void rstd_rows(const float* PSQ, float* RSTD, int gtid, int nthreads) {
    for (int i = gtid; i < M * 8; i += nthreads) { const f32x4 a = *(const f32x4*)(PSQ + (size_t)i * 8), b2 = *(const f32x4*)(PSQ + (size_t)i * 8 + 4);
        float s = (a.x + a.y) + (a.z + a.w) + (b2.x + b2.y) + (b2.z + b2.w); s = red8(s);
        if ((i & 7) == 0) RSTD[i >> 3] = 1.0f / sqrtf(s * (1.f / D) + NORM_EPS); }
}
__device__ __forceinline__ void ratio_rows(const float* ssq, float* RAT, float inv_n, int gtid, int nthreads) {
    for (int i = gtid; i < M * 8; i += nthreads) { const float* p = ssq + (size_t)i * 16;
        const f32x4 a = *(const f32x4*)p, b = *(const f32x4*)(p + 4), c = *(const f32x4*)(p + 8), d = *(const f32x4*)(p + 12); const f32x4 t = (a + b) + (c + d);
        const float sg = 1.0f / sqrtf(((t[0] + t[1]) + (t[2] + t[3])) * inv_n + INNER_EPS); const float sn = __shfl_down(sg, 1);
        RAT[i] = ((i & 7) == 7) ? sg : sg / sn; }
}
__device__ __forceinline__ void conv_item(const bf16* XBC, bf16* XBC2, const float* cw, const float* cb, int it, int lane) {
    const int tb = it / 20, cbk = it - tb * 20, m0 = tb * 32, c0 = cbk * 512 + lane * 8;
    float w[8][4], bias[8];
#pragma unroll
    for (int i = 0; i < 8; ++i) { const f32x4 ww = *(const f32x4*)(cw + (size_t)(c0 + i) * 4); w[i][0] = ww.x; w[i][1] = ww.y; w[i][2] = ww.z; w[i][3] = ww.w; }
    { const f32x4 b0 = *(const f32x4*)(cb + c0), b1 = *(const f32x4*)(cb + c0 + 4); bias[0] = b0.x; bias[1] = b0.y; bias[2] = b0.z; bias[3] = b0.w; bias[4] = b1.x; bias[5] = b1.y; bias[6] = b1.z; bias[7] = b1.w; }
    float h0[8], h1[8], h2[8];
    const bf16* src = XBC + (size_t)m0 * S_CONV + c0; bf16* dst = XBC2 + (size_t)m0 * S_CONV + c0;
    if ((m0 % T) == 0) {
#pragma unroll
        for (int i = 0; i < 8; ++i) { h0[i] = 0.f; h1[i] = 0.f; h2[i] = 0.f; }
    } else {
        bf8_to_f32(*(const v4u*)(src - 3 * (size_t)S_CONV), h0); bf8_to_f32(*(const v4u*)(src - 2 * (size_t)S_CONV), h1); bf8_to_f32(*(const v4u*)(src - 1 * (size_t)S_CONV), h2);
    }
    for (int r0 = 0; r0 < 32; r0 += 8) {
        v4u raw[8];
#pragma unroll
        for (int r = 0; r < 8; ++r) raw[r] = *(const v4u*)(src + (size_t)(r0 + r) * S_CONV);
#pragma unroll
        for (int r = 0; r < 8; ++r) {
            float cur[8], o[8]; bf8_to_f32(raw[r], cur);
#pragma unroll
            for (int i = 0; i < 8; ++i) { const float a = bias[i] + w[i][0] * h0[i] + w[i][1] * h1[i] + w[i][2] * h2[i] + w[i][3] * cur[i]; o[i] = silu(a); h0[i] = h1[i]; h1[i] = h2[i]; h2[i] = cur[i]; }
            v4u ov; ov.x = pk2(o[0], o[1]); ov.y = pk2(o[2], o[3]); ov.z = pk2(o[4], o[5]); ov.w = pk2(o[6], o[7]);
            *(v4u*)(dst + (size_t)(r0 + r) * S_CONV) = ov;
        }
    }
}
struct CvSet { float v[16]; };
struct CvPlan { const float *WA, *WG, *WU, *WD, *gA, *gGU, *dsrc; unsigned char* ws; };
template <class T_> __device__ __forceinline__ T_ sel(bool c, T_ a, T_ b) { return c ? a : b; }
struct CvState { const float *W, *gbase, *dsrc; bf16 *T, *ddst; int K, N, KB, gmask, kb, nb, K2; bool gu, up, has_gain, real; };
template <int LAYER> __device__ __forceinline__ CvState cv_init(const CvPlan& P, int s) {
    constexpr size_t oA = LAYER ? WS2_WOUT : WS_WOUT0, oGU = LAYER ? WS2_WGU : WS_WGU, oD = LAYER ? WS2_WDN : WS_WDN;
    constexpr int KA = LAYER ? 4096 : 8192, kshA = LAYER ? 8 : 9, gmaskA = LAYER ? 511 : -1;
    constexpr int nA = (KA >> 4) * 64, nG = 256 * 172, nranks = (nA + 3 * nG) / 128, n8 = (nranks - 1024) / 4;
    static_assert(128 * nranks == nA + 3 * nG && nA % 512 == 0 && nG % 512 == 0 && nranks >= 1024 && (nranks & 3) == 0 && n8 <= 256, "item count");
    const int wg = s >> 3, w = s & 7;
    const int rank = wg < n8 ? s : 8 * n8 + 4 * (wg - n8) + w;
    const int it = (rank >> 2) * 512 + (rank & 3);
    const bool isA = it < nA, isG = !isA && it < nA + nG, isU = !isA && !isG && it < nA + 2 * nG, isGU = isG || isU;
    const int r = isA ? it : isG ? it - nA : isU ? it - nA - nG : it - nA - 2 * nG;
    const int nbD = (int)((unsigned)r / 688u);
    CvState S; S.real = wg < n8 || w < 4;
    S.kb = isA ? (r & ((1 << kshA) - 1)) : isGU ? (r & 255) : r - nbD * 688;
    S.nb = isA ? (r >> kshA) : isGU ? (r >> 8) : nbD;
    S.KB = isA ? (KA >> 4) : isGU ? 256 : 688;
    S.K = isA ? KA : isGU ? 4096 : 11008; S.N = isGU ? 11008 : 4096; S.K2 = S.real ? S.K * 2 : 32;
    S.W = sel(isA, P.WA, sel(isG, P.WG, sel(isU, P.WU, P.WD))); S.gbase = sel(isA, P.gA, P.gGU); S.gmask = isA ? gmaskA : 4095;
    S.T = (bf16*)(P.ws + (isA ? oA : isGU ? oGU : oD)); S.gu = isGU; S.up = isU; S.has_gain = S.real && (isA || isGU);
    S.dsrc = P.dsrc; S.ddst = (bf16*)(P.ws + WS_DUMMY) + (s >> 3) * 1024;
    return S;
}
__device__ __forceinline__ void cv_issue(CvState& S, CvSet& V, float& gv, bf16*& dst, int lane) {
    const int k0 = S.kb * 16, n0 = S.nb * 64;
    const int drow0 = S.gu ? ((n0 >> 7) * 256 + (n0 & 127) + (S.up ? 128 : 0)) : n0;
    const float* src = sel(S.real, S.W + (size_t)k0 * S.N + n0, S.dsrc);
    const int Nl = S.real ? S.N : 0;
    dst = sel(S.real, S.T + (size_t)drow0 * S.K + k0, S.ddst);
#pragma unroll
    for (int j = 0; j < 16; ++j) V.v[j] = __builtin_nontemporal_load(src + (size_t)j * Nl + lane);
    gv = S.gbase[(k0 & S.gmask) + (lane & 15)];
    const bool wrap = S.kb + 4 >= S.KB; S.kb = wrap ? S.kb + 4 - S.KB : S.kb + 4; S.nb += wrap ? 1 : 0;
}
__device__ __forceinline__ void cv_finish(const CvSet& V, const float graw, bool has_gain, bf16* dst, int K2, int lane) {
    const float gv = has_gain ? graw : 1.0f;
    unsigned p[8];
#pragma unroll
    for (int j = 0; j < 8; ++j) {
        const float g0 = __builtin_bit_cast(float, __builtin_amdgcn_readlane(__builtin_bit_cast(int, gv), 2 * j)), g1 = __builtin_bit_cast(float, __builtin_amdgcn_readlane(__builtin_bit_cast(int, gv), 2 * j + 1));
        p[j] = pk2(V.v[2 * j] * g0, V.v[2 * j + 1] * g1); }
    unsigned char* o = (unsigned char*)dst + (unsigned)(lane * K2);
    *(v4u*)o = (v4u){p[0], p[1], p[2], p[3]}; *(v4u*)(o + 16) = (v4u){p[4], p[5], p[6], p[7]};
}

struct SsdRegs { v4u rB[2], rC[2], rX, rZ; float rdt; };
struct SsdCtx { const bf16* XBC2; const bf16* Z; const float* DTV; bf16* YG; float* SSQ; size_t mbase; int h, g, tid, lane, w, r16, q4, brow, bc8, xrow, xc8, pb, lb0; float a, dsk; };
__device__ __forceinline__ void ssd_load(SsdRegs& R, const SsdCtx& X, int cc) {
    const size_t m0 = X.mbase + (size_t)cc * 64;
#pragma unroll
    for (int i = 0; i < 2; ++i) { const bf16* p = X.XBC2 + (m0 + X.brow + 32 * i) * S_CONV + 8192 + X.g * 128 + X.bc8 * 8; R.rB[i] = *(const v4u*)p; R.rC[i] = *(const v4u*)(p + 1024); }
    R.rX = *(const v4u*)(X.XBC2 + (m0 + X.xrow) * S_CONV + X.h * 64 + X.xc8 * 8); R.rZ = *(const v4u*)(X.Z + (m0 + X.xrow) * S_DI + X.h * 64 + X.xc8 * 8);
    R.rdt = X.DTV[(m0 + X.lane) * 128 + X.h];
}
__device__ __forceinline__ void ssd_chunk_body(LAS unsigned char* lds, const SsdCtx& X, SsdRegs& R, f32x4 (&st)[4], int c, CvState& CS, CvSet& CI, float& gI, bf16*& dI, const CvSet& CF, const float gF, bf16* dF, int k2F) {
    constexpr int SB = 144, SX = 80, SY = 68;
    LAS bf16* Bs = (LAS bf16*)lds;
    LAS bf16* Cs = (LAS bf16*)(lds + 18432);
    LAS bf16* Xs = (LAS bf16*)(lds + 36864);
    LAS bf16* Xws = (LAS bf16*)(lds + 47104);
    LAS bf16* Ms = (LAS bf16*)(lds + 57344);
    LAS bf16* Sb0 = (LAS bf16*)(lds + 67584);
    LAS float* csA = (LAS float*)(lds + 104448); LAS float* dtA = csA + 64; LAS float* ecsA = csA + 128;
    LAS float* Ys = (LAS float*)lds;
    LAS bf16* Zs = (LAS bf16*)(lds + 105216);
    const int lane = X.lane, w = X.w, r16 = X.r16, q4 = X.q4, brow = X.brow, bc8 = X.bc8, xrow = X.xrow, xc8 = X.xc8, pb = X.pb, lb0 = X.lb0, h = X.h;
    const float rdt = R.rdt;
    float cs = wave_scan_incl(rdt * X.a);
    const float cs_end = __builtin_bit_cast(float, __builtin_amdgcn_readlane(__builtin_bit_cast(int, cs), 63));
    const float wv = fexp(cs_end - cs) * rdt, e_end = fexp(cs_end);
    const float wl = __shfl(wv, xrow);
    __syncthreads();
#pragma unroll
    for (int i = 0; i < 2; ++i) { *(LAS v4u*)(Bs + (brow + 32 * i) * SB + bc8 * 8) = R.rB[i]; *(LAS v4u*)(Cs + (brow + 32 * i) * SB + bc8 * 8) = R.rC[i]; }
    *(LAS v4u*)(Xs + xrow * SX + xc8 * 8) = R.rX; *(LAS v4u*)(Zs + xrow * SX + xc8 * 8) = R.rZ;
    { const unsigned xq[4] = {R.rX.x, R.rX.y, R.rX.z, R.rX.w}; const f32x2 wlv = {wl, wl}; unsigned xo[4];
#pragma unroll
      for (int p = 0; p < 4; ++p) { const f32x2 f = (f32x2){__builtin_bit_cast(float, xq[p] << 16), __builtin_bit_cast(float, xq[p] & 0xffff0000u)} * wlv; xo[p] = pk2(f.x, f.y); }
      *(LAS v4u*)(Xws + xrow * SX + xc8 * 8) = (v4u){xo[0], xo[1], xo[2], xo[3]}; }
    if (w == 0) { csA[lane] = cs; dtA[lane] = rdt; ecsA[lane] = fexp(cs); }
    const size_t m0 = X.mbase + (size_t)c * 64;
    __syncthreads();
    ssd_load(R, X, c + 2 < T / 64 ? c + 2 : T / 64 - 1);
    cv_issue(CS, CI, gI, dI, lane);
    const LAS bf16* Sc = Sb0 + (c & 1) * 9216; LAS bf16* Sn = Sb0 + ((c & 1) ^ 1) * 9216;
    for (int ti = w; ti < 10; ti += 8) {
        const int lb = ti >= 6 ? 3 : (ti >= 3 ? 2 : (ti >= 1 ? 1 : 0)), sb = ti - ((lb * (lb + 1)) >> 1);
        bf16x8 fb[4], fc[4];
#pragma unroll
        for (int kk = 0; kk < 4; ++kk) { fb[kk] = frag_row(Bs, SB, 16 * sb, 32 * kk, lane); fc[kk] = frag_row(Cs, SB, 16 * lb, 32 * kk, lane); }
        const float csl = csA[16 * lb + r16];
        const f32x4 css = *(const LAS f32x4*)(csA + 16 * sb + 4 * q4), dts = *(const LAS f32x4*)(dtA + 16 * sb + 4 * q4);
        __builtin_amdgcn_sched_barrier(0);
        f32x4 acc = (f32x4){0.f, 0.f, 0.f, 0.f};
#pragma unroll
        for (int kk = 0; kk < 4; ++kk) acc = MFMA16(fb[kk], fc[kk], acc);
        float m[4];
#pragma unroll
        for (int j = 0; j < 4; ++j) { const bool ok = (sb < lb) || (4 * q4 + j <= r16); m[j] = ok ? acc[j] * fexp(csl - css[j]) * dts[j] : 0.f; }
        *(LAS v2u*)(Ms + (16 * lb + r16) * SX + 16 * sb + 4 * q4) = (v2u){pk2(m[0], m[1]), pk2(m[2], m[3])};
    }
    f32x4 y0 = (f32x4){0.f, 0.f, 0.f, 0.f}, y1 = y0;
#pragma unroll
    for (int kk = 0; kk < 4; ++kk) { const bf16x8 af = frag_row(Sc, SB, 16 * pb, 32 * kk, lane);
        y0 = MFMA16(af, frag_row(Cs, SB, 16 * lb0, 32 * kk, lane), y0); y1 = MFMA16(af, frag_row(Cs, SB, 16 * lb0 + 16, 32 * kk, lane), y1); }
    { const float e0 = ecsA[16 * lb0 + r16], e1 = ecsA[16 * lb0 + 16 + r16]; y0 = y0 * e0; y1 = y1 * e1; }
#pragma unroll
    for (int i = 0; i < 4; ++i) st[i] = st[i] * e_end;
#pragma unroll
    for (int kl = 0; kl < 2; ++kl) { const bf16x8 af = frag_tr(Bs, SB, 32 * kl, 16 * w, lane);
#pragma unroll
        for (int i = 0; i < 4; ++i) st[i] = MFMA16(af, frag_tr(Xws, SX, 32 * kl, 16 * i, lane), st[i]); }
#pragma unroll
    for (int i = 0; i < 4; ++i) *(LAS v2u*)(Sn + (16 * i + r16) * SB + 16 * w + 4 * q4) = (v2u){pk2(st[i][0], st[i][1]), pk2(st[i][2], st[i][3])};
    __syncthreads();
    for (int ks = 0; ks <= (w >> 2); ++ks) { const bf16x8 af = frag_tr(Xs, SX, 32 * ks, 16 * pb, lane);
        y0 = MFMA16(af, frag_row(Ms, SX, 16 * lb0, 32 * ks, lane), y0); y1 = MFMA16(af, frag_row(Ms, SX, 16 * lb0 + 16, 32 * ks, lane), y1); }
    *(LAS f32x4*)(Ys + (16 * lb0 + r16) * SY + 16 * pb + 4 * q4) = y0; *(LAS f32x4*)(Ys + (16 * lb0 + 16 + r16) * SY + 16 * pb + 4 * q4) = y1;
    __syncthreads();
    { const v4u zr = *(const LAS v4u*)(Zs + xrow * SX + xc8 * 8), xr = *(const LAS v4u*)(Xs + xrow * SX + xc8 * 8);
      const f32x4 ya = *(const LAS f32x4*)(Ys + xrow * SY + xc8 * 8), yb = *(const LAS f32x4*)(Ys + xrow * SY + xc8 * 8 + 4);
      const unsigned zw[4] = {zr.x, zr.y, zr.z, zr.w}, xw4[4] = {xr.x, xr.y, xr.z, xr.w}; const f32x2 yv[4] = {{ya[0], ya[1]}, {ya[2], ya[3]}, {yb[0], yb[1]}, {yb[2], yb[3]}};
      const f32x2 dskv = {X.dsk, X.dsk}, nl2e = {-1.44269504f, -1.44269504f}, one = {1.0f, 1.0f}; f32x2 ssq2 = {0.f, 0.f}; unsigned ow[4];
#pragma unroll
      for (int p = 0; p < 4; ++p) { const f32x2 z = {__builtin_bit_cast(float, zw[p] << 16), __builtin_bit_cast(float, zw[p] & 0xffff0000u)}, xx = {__builtin_bit_cast(float, xw4[p] << 16), __builtin_bit_cast(float, xw4[p] & 0xffff0000u)};
          const f32x2 y = yv[p] + dskv * xx; const f32x2 t = z * nl2e; const f32x2 d = (f32x2){__builtin_amdgcn_exp2f(t.x), __builtin_amdgcn_exp2f(t.y)} + one;
          const f32x2 yg = (y * z) * (f32x2){__builtin_amdgcn_rcpf(d.x), __builtin_amdgcn_rcpf(d.y)};
          ssq2 = ssq2 + yg * yg; ow[p] = pk2(yg.x, yg.y); }
      float ssq = ssq2.x + ssq2.y;
      *(v4u*)(X.YG + (m0 + xrow) * S_DI + h * 64 + xc8 * 8) = (v4u){ow[0], ow[1], ow[2], ow[3]};
      ssq = red8(ssq); X.SSQ[(m0 + xrow) * 128 + h] = ssq; }
    cv_finish(CF, gF, CS.has_gain, dF, k2F, lane);
}
__device__ __forceinline__ void ssd_chunk_unit(LAS unsigned char* lds, int b, int h, const bf16* XBC2, const bf16* Z, const float* DTV, const float* a_log, const float* dskip, bf16* YG, float* SSQ, int tid, const CvPlan& P, int wg) {
    SsdCtx X; X.XBC2 = XBC2; X.Z = Z; X.DTV = DTV; X.YG = YG; X.SSQ = SSQ; X.mbase = (size_t)b * T; X.h = h; X.g = h >> 4; X.tid = tid; X.lane = tid & 63; X.w = __builtin_amdgcn_readfirstlane(tid >> 6);
    X.r16 = X.lane & 15; X.q4 = X.lane >> 4; X.brow = tid >> 4; X.bc8 = tid & 15; X.xrow = tid >> 3; X.xc8 = tid & 7; X.pb = X.w & 3; X.lb0 = 2 * (X.w >> 2); X.a = -expf(a_log[h]); X.dsk = dskip[h];
    __syncthreads();
    for (int i = tid; i < (10240 + 18432) / 16; i += 512) *(LAS v4u*)(lds + 57344 + i * 16) = (v4u){0u, 0u, 0u, 0u};
    f32x4 st[4];
#pragma unroll
    for (int i = 0; i < 4; ++i) st[i] = (f32x4){0.f, 0.f, 0.f, 0.f};
    SsdRegs RA, RB;
    ssd_load(RA, X, 0); ssd_load(RB, X, 1);
    CvState CS = cv_init<0>(P, wg * 8 + X.w);
    CvSet CA, CB; float gA = 0.f, gB = 0.f; bf16 *dA = CS.ddst, *dB = CS.ddst;
#pragma unroll
    for (int j = 0; j < 16; ++j) CB.v[j] = 0.f;
    ssd_chunk_body(lds, X, RA, st, 0, CS, CA, gA, dA, CB, gB, dB, 32); ssd_chunk_body(lds, X, RB, st, 1, CS, CB, gB, dB, CA, gA, dA, CS.K2);
    for (int c = 2; c < T / 64; c += 2) { ssd_chunk_body(lds, X, RA, st, c, CS, CA, gA, dA, CB, gB, dB, CS.K2); ssd_chunk_body(lds, X, RB, st, c + 1, CS, CB, gB, dB, CA, gA, dA, CS.K2); }
    cv_finish(CB, gB, CS.has_gain, dB, CS.K2, X.lane);
}
__device__ __forceinline__ void ssd_norm_row(bf16* yrow, const float* ssqrow, const float* nw, int lane) {
    float v = ssqrow[lane], w = ssqrow[64 + lane]; v = red16(v); w = red16(w);
    float rs[8];
#pragma unroll
    for (int gq = 0; gq < 4; ++gq) { rs[gq] = 1.0f / sqrtf(__shfl(v, 16 * gq) * (1.f / 1024.f) + INNER_EPS); rs[4 + gq] = 1.0f / sqrtf(__shfl(w, 16 * gq) * (1.f / 1024.f) + INNER_EPS); }
#pragma unroll
    for (int j = 0; j < 16; ++j) { const int c = (j * 64 + lane) * 8; float f[8]; bf8_to_f32(*(const v4u*)(yrow + c), f);
        const f32x4 w0 = *(const f32x4*)(nw + c), w1 = *(const f32x4*)(nw + c + 4); const float r = rs[j >> 1];
        v4u ov; ov.x = pk2(f[0] * r * w0.x, f[1] * r * w0.y); ov.y = pk2(f[2] * r * w0.z, f[3] * r * w0.w); ov.z = pk2(f[4] * r * w1.x, f[5] * r * w1.y); ov.w = pk2(f[6] * r * w1.z, f[7] * r * w1.w);
        *(v4u*)(yrow + c) = ov; }
}
__device__ __forceinline__ void gla_prep_chunk(const float* GKL, const float* gk_up, const float* gk_bias, const bf16* PROJ, bf16* QD, bf16* KI, float* EE, bf16* PB, LAS unsigned char* lds, int ch, int tid) {
    f32x4 up[16];
#pragma unroll
    for (int r = 0; r < 16; ++r) up[r] = *(const f32x4*)(gk_up + (size_t)r * 2048 + tid * 4);
    const f32x4 bias = *(const f32x4*)(gk_bias + tid * 4);
    f32x4 cs = (f32x4){0.f, 0.f, 0.f, 0.f};
    const size_t m0 = (size_t)ch * 64;
    LAS float* gls = (LAS float*)lds;
    for (int i = tid; i < 64 * 16; i += 512) { const float* g4 = GKL + m0 * 16 + i; gls[i] = (g4[0] + g4[(size_t)M * 16]) + (g4[(size_t)2 * M * 16] + g4[(size_t)3 * M * 16]); }
    __syncthreads();
#pragma unroll 2
    for (int l = 0; l < 64; ++l) {
        const size_t m = m0 + l;
        const LAS f32x4* gl = (const LAS f32x4*)(gls + l * 16); f32x4 z = bias;
#pragma unroll
        for (int r4 = 0; r4 < 4; ++r4) { const f32x4 gq = gl[r4]; z = z + up[4 * r4] * gq[0]; z = z + up[4 * r4 + 1] * gq[1]; z = z + up[4 * r4 + 2] * gq[2]; z = z + up[4 * r4 + 3] * gq[3]; }
        const v2u qr = *(const v2u*)(PROJ + m * G_PROJ + tid * 4), kr = *(const v2u*)(PROJ + m * G_PROJ + 2048 + tid * 4);
        float q[4], k[4];
        q[0] = __builtin_bit_cast(float, qr.x << 16); q[1] = __builtin_bit_cast(float, qr.x & 0xffff0000u); q[2] = __builtin_bit_cast(float, qr.y << 16); q[3] = __builtin_bit_cast(float, qr.y & 0xffff0000u);
        k[0] = __builtin_bit_cast(float, kr.x << 16); k[1] = __builtin_bit_cast(float, kr.x & 0xffff0000u); k[2] = __builtin_bit_cast(float, kr.y << 16); k[3] = __builtin_bit_cast(float, kr.y & 0xffff0000u);
        float qd[4], ki[4];
#pragma unroll
        for (int j = 0; j < 4; ++j) { const float ls = fminf(z[j], 0.f) - 0.693147181f * __builtin_amdgcn_logf(1.0f + fexp(-fabsf(z[j]))); cs[j] += ls * (1.f / 16.f); qd[j] = q[j] * 0.0625f * fexp(cs[j]); ki[j] = k[j] * fexp(-cs[j]); }
        *(v2u*)(QD + m * 2048 + tid * 4) = (v2u){pk2(qd[0], qd[1]), pk2(qd[2], qd[3])};
        *(v2u*)(KI + m * 2048 + tid * 4) = (v2u){pk2(ki[0], ki[1]), pk2(ki[2], ki[3])};
    }
    *(f32x4*)(EE + (size_t)ch * 2048 + tid * 4) = (f32x4){fexp(cs[0]), fexp(cs[1]), fexp(cs[2]), fexp(cs[3])};
    asm volatile("s_waitcnt vmcnt(0)" ::: "memory"); __syncthreads();
    { const int lane = tid & 63, w = __builtin_amdgcn_readfirstlane(tid >> 6), r16 = lane & 15, q4 = lane >> 4;
      const bf16* qb = QD + (m0 + r16) * 2048 + w * 256 + 8 * q4; const bf16* kb = KI + (m0 + r16) * 2048 + w * 256 + 8 * q4;
      bf16* pb = PB + ((size_t)(ch * 8 + w) * 64 + r16) * 64 + 4 * q4;
#pragma unroll 1
      for (int tl = 0; tl < 4; ++tl) {
          bf16x8 bq[8];
#pragma unroll
          for (int kk = 0; kk < 8; ++kk) bq[kk] = *(const bf16x8*)(qb + (size_t)(16 * tl) * 2048 + 32 * kk);
#pragma unroll 1
          for (int sb = 0; sb <= tl; ++sb) {
              f32x4 acc = (f32x4){0.f, 0.f, 0.f, 0.f};
#pragma unroll
              for (int kk = 0; kk < 8; ++kk) acc = MFMA16(*(const bf16x8*)(kb + (size_t)(16 * sb) * 2048 + 32 * kk), bq[kk], acc);
              float mm[4];
#pragma unroll
              for (int j = 0; j < 4; ++j) { const bool ok = (sb < tl) || (4 * q4 + j <= r16); mm[j] = ok ? acc[j] : 0.f; }
              *(v2u*)(pb + (size_t)(16 * tl) * 64 + 16 * sb) = (v2u){pk2(mm[0], mm[1]), pk2(mm[2], mm[3])};
          }
          if ((tl & 1) == 0) *(v2u*)(pb + (size_t)(16 * tl) * 64 + 16 * (tl + 1)) = (v2u){0u, 0u};
      }
    }
}
struct GlaRegs { v4u rQ[4], rK[4], rVG, rP; f32x4 rE; };
struct GlaCtx { const bf16* QD; const bf16* KI; const bf16* PROJ; const float* EE; const bf16* PB; bf16* O; float* SSQ2; size_t mbase; int b, h, sl, tid, lane, w, r16, q4, qrow, qc8, vrow, vc8, vb, lb, vgoff; };
__device__ __forceinline__ void gla_load(GlaRegs& R, const GlaCtx& X, int cc) {
    const size_t m0 = X.mbase + (size_t)cc * 64;
#pragma unroll
    for (int i = 0; i < 4; ++i) { const size_t o = (m0 + X.qrow + 16 * i) * 2048 + X.h * 256 + X.qc8 * 8; R.rQ[i] = *(const v4u*)(X.QD + o); R.rK[i] = *(const v4u*)(X.KI + o); }
    R.rVG = *(const v4u*)(X.PROJ + (m0 + X.vrow) * G_PROJ + X.vgoff + X.h * 512 + X.sl * 32 + X.vc8 * 8);
    R.rE = *(const f32x4*)(X.EE + (size_t)(X.b * (T / 64) + cc) * 2048 + X.h * 256 + X.lane * 4);
    R.rP = *(const v4u*)(X.PB + ((size_t)((X.b * (T / 64) + cc) * 8 + X.h) * 64 + (X.tid >> 3)) * 64 + (X.tid & 7) * 8);
}
__device__ __forceinline__ void gla_chunk_body(LAS unsigned char* lds, const GlaCtx& X, GlaRegs& R, f32x4 (&st)[2][2], int c) {
    constexpr int SQ = 272, SV = 40, SP = 80, SO = 36;
    LAS bf16* Qs = (LAS bf16*)lds;
    LAS bf16* Ks = (LAS bf16*)(lds + 34816);
    LAS bf16* Vs = (LAS bf16*)(lds + 69632);
    LAS bf16* Ps = (LAS bf16*)(lds + 74752);
    LAS bf16* Sb0 = (LAS bf16*)(lds + 84992);
    LAS float* Os = (LAS float*)(lds + 119808);
    LAS float* eA = (LAS float*)(lds + 129024);
    LAS bf16* Gs = (LAS bf16*)(lds + ((c & 1) ? 137216 : 132096));
    const int tid = X.tid, lane = X.lane, w = X.w, r16 = X.r16, q4 = X.q4, qrow = X.qrow, qc8 = X.qc8, vrow = X.vrow, vc8 = X.vc8, vb = X.vb, lb = X.lb, h = X.h, sl = X.sl;
#pragma unroll
    for (int i = 0; i < 4; ++i) { *(LAS v4u*)(Qs + (qrow + 16 * i) * SQ + qc8 * 8) = R.rQ[i]; *(LAS v4u*)(Ks + (qrow + 16 * i) * SQ + qc8 * 8) = R.rK[i]; }
    *(LAS v4u*)((tid < 256 ? Vs : Gs) + vrow * SV + vc8 * 8) = R.rVG;
    if (tid < 64) *(LAS f32x4*)(eA + tid * 4) = R.rE;
    *(LAS v4u*)(Ps + (tid >> 3) * SP + (tid & 7) * 8) = R.rP;
    const size_t m0 = X.mbase + (size_t)c * 64;
    __syncthreads();
    gla_load(R, X, c + 2 < T / 64 ? c + 2 : T / 64 - 1);
    const LAS bf16* Sc = Sb0 + (c & 1) * 8704; LAS bf16* Sn = Sb0 + ((c & 1) ^ 1) * 8704;
    f32x4 o = (f32x4){0.f, 0.f, 0.f, 0.f};
#pragma unroll
    for (int kk = 0; kk < 8; ++kk) o = MFMA16(frag_row(Sc, SQ, 16 * vb, 32 * kk, lane), frag_row(Qs, SQ, 16 * lb, 32 * kk, lane), o);
    for (int ks = 0; ks <= (lb >> 1); ++ks) o = MFMA16(frag_tr(Vs, SV, 32 * ks, 16 * vb, lane), frag_row(Ps, SP, 16 * lb, 32 * ks, lane), o);
    *(LAS f32x4*)(Os + (16 * lb + r16) * SO + 16 * vb + 4 * q4) = o;
#pragma unroll
    for (int kl = 0; kl < 2; ++kl) { const bf16x8 bv0 = frag_tr(Vs, SV, 32 * kl, 0, lane), bv1 = frag_tr(Vs, SV, 32 * kl, 16, lane);
#pragma unroll
        for (int i = 0; i < 2; ++i) { const bf16x8 af = frag_tr(Ks, SQ, 32 * kl, 16 * (2 * w + i), lane); st[i][0] = MFMA16(af, bv0, st[i][0]); st[i][1] = MFMA16(af, bv1, st[i][1]); } }
#pragma unroll
    for (int i = 0; i < 2; ++i) { const f32x4 e = *(const LAS f32x4*)(eA + 16 * (2 * w + i) + 4 * q4); st[i][0] = st[i][0] * e; st[i][1] = st[i][1] * e;
#pragma unroll
        for (int v2 = 0; v2 < 2; ++v2) *(LAS v2u*)(Sn + (16 * v2 + r16) * SQ + 16 * (2 * w + i) + 4 * q4) = (v2u){pk2(st[i][v2][0], st[i][v2][1]), pk2(st[i][v2][2], st[i][v2][3])}; }
    __syncthreads();
    { const int erow = tid >> 3, ec4 = tid & 7;
        const f32x4 oa = *(const LAS f32x4*)(Os + erow * SO + ec4 * 4); const v2u gr = *(const LAS v2u*)(Gs + erow * SV + ec4 * 4);
        float ssq = (oa[0] * oa[0] + oa[1] * oa[1]) + (oa[2] * oa[2] + oa[3] * oa[3]);
        const float g0 = __builtin_bit_cast(float, gr.x << 16), g1 = __builtin_bit_cast(float, gr.x & 0xffff0000u), g2 = __builtin_bit_cast(float, gr.y << 16), g3 = __builtin_bit_cast(float, gr.y & 0xffff0000u);
        *(v2u*)(X.O + (m0 + erow) * D + h * 512 + sl * 32 + ec4 * 4) = (v2u){pk2(oa[0] * silu(g0), oa[1] * silu(g1)), pk2(oa[2] * silu(g2), oa[3] * silu(g3))};
        ssq = red8(ssq); X.SSQ2[(m0 + erow) * 128 + h * 16 + sl] = ssq; }
}
__device__ __forceinline__ void gla_chunk_unit(LAS unsigned char* lds, int b, int h, int sl, const bf16* QD, const bf16* KI, const bf16* PROJ, const float* EE, const bf16* PB, bf16* O, float* SSQ2, int tid) {
    GlaCtx X; X.QD = QD; X.KI = KI; X.PROJ = PROJ; X.EE = EE; X.PB = PB; X.O = O; X.SSQ2 = SSQ2; X.mbase = (size_t)b * T; X.b = b; X.h = h; X.sl = sl; X.tid = tid; X.lane = tid & 63; X.w = __builtin_amdgcn_readfirstlane(tid >> 6);
    X.r16 = X.lane & 15; X.q4 = X.lane >> 4; X.qrow = tid >> 5; X.qc8 = tid & 31; X.vrow = (tid >> 2) & 63; X.vc8 = tid & 3; X.vb = X.w & 1; X.lb = X.w >> 1; X.vgoff = tid < 256 ? 4096 : 8192;
    __syncthreads();
    for (int i = tid; i < 17408 / 16; i += 512) *(LAS v4u*)(lds + 84992 + i * 16) = (v4u){0u, 0u, 0u, 0u};
    f32x4 st[2][2];
#pragma unroll
    for (int i = 0; i < 2; ++i) { st[i][0] = (f32x4){0.f, 0.f, 0.f, 0.f}; st[i][1] = st[i][0]; }
    GlaRegs RA, RB;
    gla_load(RA, X, 0); gla_load(RB, X, 1);
    gla_chunk_body(lds, X, RA, st, 0); gla_chunk_body(lds, X, RB, st, 1);
    for (int c = 2; c < T / 64; c += 2) { gla_chunk_body(lds, X, RA, st, c); gla_chunk_body(lds, X, RB, st, c + 1); }
}
__device__ __forceinline__ void gla_norm_row(bf16* orow, const bf16* grow, const float* ssqrow, const float* nw, int lane) {
    float v = ssqrow[lane], w = ssqrow[64 + lane]; v = red16(v); w = red16(w);
    float rs[8];
#pragma unroll
    for (int gq = 0; gq < 4; ++gq) { rs[gq] = 1.0f / sqrtf(__shfl(v, 16 * gq) * (1.f / 512.f) + INNER_EPS); rs[4 + gq] = 1.0f / sqrtf(__shfl(w, 16 * gq) * (1.f / 512.f) + INNER_EPS); }
#pragma unroll
    for (int j = 0; j < 8; ++j) { const int c = (j * 64 + lane) * 8; float f[8], gt[8]; bf8_to_f32(*(const v4u*)(orow + c), f); bf8_to_f32(*(const v4u*)(grow + c), gt);
        const f32x4 w0 = *(const f32x4*)(nw + (c & 511)), w1 = *(const f32x4*)(nw + (c & 511) + 4); const float r = rs[j];
        v4u ov; ov.x = pk2(f[0] * r * w0.x * silu(gt[0]), f[1] * r * w0.y * silu(gt[1])); ov.y = pk2(f[2] * r * w0.z * silu(gt[2]), f[3] * r * w0.w * silu(gt[3]));
        ov.z = pk2(f[4] * r * w1.x * silu(gt[4]), f[5] * r * w1.y * silu(gt[5])); ov.w = pk2(f[6] * r * w1.z * silu(gt[6]), f[7] * r * w1.w * silu(gt[7]));
        *(v4u*)(orow + c) = ov; }
}

struct Args { const float* in[25]; float* out; unsigned char* ws; int ph_lo, ph_hi; };
__global__ void __launch_bounds__(NWAVES * 64, 2) trunk_fwd(Args args) {
    extern __shared__ __attribute__((aligned(16))) unsigned char lds_raw[];
    LAS unsigned char* lds = (LAS unsigned char*)lds_raw;
    volatile LAS unsigned* MISC = (volatile LAS unsigned*)(lds + MISC_OFF);
    const int tid = threadIdx.x, lane = tid & 63, wave = __builtin_amdgcn_readfirstlane(tid >> 6);
    const int G = gridDim.x, bx = blockIdx.x;
    const int vcu = (G % 8 == 0) ? (bx % 8) * (G / 8) + bx / 8 : bx;
    const int gw = vcu * NWAVES + wave, NGW = G * NWAVES;
    unsigned char* ws = args.ws;
    const int lo = args.ph_lo, hi = args.ph_hi;
    for (int u = tid; u < (LDS_BYTES - LDSCTL_OFF) / 4; u += NWAVES * 64) ((LAS unsigned*)(lds + LDSCTL_OFF))[u] = 0u;
    __syncthreads();
    XcdBarrier bar; bar.bar = (unsigned*)(ws + WS_CTL) + CW_BAR; bar.x = 0; bar.st = nullptr;
    if (hi - lo > 1) bar = xcd_barrier_post((unsigned*)(ws + WS_CTL) + CW_BAR, MISC + 8);
#define IN(k) (lo <= (k) && (k) < hi)
#define SEAM(k) do { if (IN(k) && IN((k) + 1)) xcd_barrier(bar); } while (0)
    const float* x = args.in[0];
    const float *l0_mixer_norm = args.in[1], *l0_in_proj = args.in[2], *l0_conv_w = args.in[3], *l0_conv_b = args.in[4], *l0_dt_bias = args.in[5], *l0_a_log = args.in[6], *l0_d = args.in[7],
                *l0_norm_w = args.in[8], *l0_out_proj = args.in[9], *l0_ffn_norm = args.in[10], *l0_w_gate = args.in[11], *l0_w_up = args.in[12], *l0_w_down = args.in[13];
    const float *l1_mixer_norm = args.in[14], *l1_in_proj = args.in[15], *l1_gk_up = args.in[16], *l1_gk_bias = args.in[17], *l1_norm_w = args.in[18], *l1_out_proj = args.in[19],
                *l1_ffn_norm = args.in[20], *l1_w_gate = args.in[21], *l1_w_up = args.in[22], *l1_w_down = args.in[23], *final_norm = args.in[24];
    float* out = args.out;
    bf16 *WIN = (bf16*)(ws + WS_WIN), *WOUT0 = (bf16*)(ws + WS_WOUT0), *WOUT1 = (bf16*)(ws + WS_WOUT1), *WGU = (bf16*)(ws + WS_WGU), *WDN = (bf16*)(ws + WS_WDN), *XN = (bf16*)(ws + WS_XN);
    bf16 *Zb = (bf16*)(ws + WS_Z), *XBC = (bf16*)(ws + WS_XBC), *XBC2 = (bf16*)(ws + WS_XBC2), *YG = (bf16*)(ws + WS_YG), *ACT = (bf16*)(ws + WS_ACT), *PROJ = (bf16*)(ws + WS_PROJ), *Ob = (bf16*)(ws + WS_O), *QD = (bf16*)(ws + WS_QD), *KI = (bf16*)(ws + WS_KI), *PBb = (bf16*)(ws + WS_PB);
    bf16 *WIN1 = (bf16*)(ws + WS2_WIN), *WOUT1b = (bf16*)(ws + WS2_WOUT), *WGU1 = (bf16*)(ws + WS2_WGU), *WDN1 = (bf16*)(ws + WS2_WDN);
    const WJob k0{l1_in_proj, WIN1, D, G_IN, 0, l1_mixer_norm, -1}, k1{l1_out_proj, WOUT1b, D, D, 0, l1_norm_w, 511}, k2{l1_w_gate, WGU1, D, DFF, 1, l1_ffn_norm, -1}, k3{l1_w_up, WGU1, D, DFF, 2, l1_ffn_norm, -1}, k4{l1_w_down, WDN1, DFF, D, 0, nullptr, -1};
    constexpr int L1_ITEMS_B = 12288;
    float *DTP = (float*)(ws + WS_DTP), *GKP = (float*)(ws + WS_GKP);
    bf16* XR = XN;
    float *PSQ = (float*)(ws + WS_PSQ), *RSTD = (float*)(ws + WS_RSTD), *RAT = (float*)(ws + WS_RAT);
    float *DT = (float*)(ws + WS_DT), *SSQ = (float*)(ws + WS_SSQ), *EE = (float*)(ws + WS_EE), *SSQ2 = (float*)(ws + WS_SSQ2);
    LAS bf16* scr = (LAS bf16*)(lds + RING_OFF + wave * 16384);

    if (IN(0)) {
        const WJob j0{l0_in_proj, WIN, D, S_IN, 0, l0_mixer_norm, -1}, j1{l0_out_proj, WOUT0, S_DI, D, 0, l0_norm_w, -1}, j2{l0_w_gate, WGU, D, DFF, 1, l0_ffn_norm, -1}, j3{l0_w_up, WGU, D, DFF, 2, l0_ffn_norm, -1}, j4{l0_w_down, WDN, DFF, D, 0, nullptr, -1};
        convert_layer(j0, j1, j2, j3, j4, scr, gw, NGW, lane, 0, wjob_items(j0));
        zero_rows_bf16(WIN + (size_t)S_IN * D, (size_t)(S_INP - S_IN) * D, vcu * 512 + tid, G * 512);
        for (int m = gw; m < M; m += NGW) cast_row_rstd(x + (size_t)m * D, XR + (size_t)m * D, RSTD + m, lane);
    }
    SEAM(0);
    if (IN(1)) {
        pg8::Gemm g{XN, WIN, M, 72 * 256, D, D, D}; pg8::StaticOrder S; S.init(M, 72 * 256, G, bx);
        pg8::EpiSsdIn E{Zb, XBC, RSTD};
        pg8::gemm_phase<pg8::EpiSsdIn, pg8::StaticOrder, true, true>(lds + RING_OFF, g, S, E);
        pg8::Gemm g2{XN, WIN, M, 256, D / 4, D, D}; pg8::KSplitOrder S2; S2.init(M, G, bx, 72, D / 4);
        pg8::EpiDtPart E2{DTP, RSTD};
        pg8::gemm_phase<pg8::EpiDtPart, pg8::KSplitOrder, true, true>(lds + RING_OFF, g2, S2, E2);
    }
    SEAM(1);
    if (IN(2)) {
        for (int it = gw; it < (M / 32) * 20; it += NGW) conv_item(XBC, XBC2, l0_conv_w, l0_conv_b, it, lane);
        for (int i = vcu * 512 + tid; i < M * 128 / 4; i += G * 512) { const f32x4 bb = *(const f32x4*)(l0_dt_bias + ((i * 4) & 127));
            f32x4 v = (*(const f32x4*)(DTP + (size_t)i * 4) + *(const f32x4*)(DTP + (size_t)M * 128 + (size_t)i * 4)) + (*(const f32x4*)(DTP + (size_t)2 * M * 128 + (size_t)i * 4) + *(const f32x4*)(DTP + (size_t)3 * M * 128 + (size_t)i * 4));
            v = (f32x4){softplus(v.x + bb.x), softplus(v.y + bb.y), softplus(v.z + bb.z), softplus(v.w + bb.w)}; *(f32x4*)(DT + (size_t)i * 4) = v; }
    }
    SEAM(2);
    if (IN(3)) {
        const CvPlan P0{l0_out_proj, l0_w_gate, l0_w_up, l0_w_down, l0_norm_w, l0_ffn_norm, l0_a_log, ws};
        for (int u = bx; u < 256; u += G) { const int xcd = u & 7, j = u >> 3, pair = xcd * 2 + (j >> 4), b = pair >> 3, gq = pair & 7, r = j & 15;
            ssd_chunk_unit(lds + RING_OFF, b, gq * 16 + r, XBC2, Zb, DT, l0_a_log, l0_d, YG, SSQ, tid, P0, u); __syncthreads(); }
    }
    SEAM(3);
    if (IN(5)) {
        pg8::Gemm g{YG, WOUT0, M, D, 1024, S_DI, S_DI}; pg8::GroupedOrder S; S.init(M, D, G, bx, 1024);
        pg8::EpiResBf16<false, true> E{XR, XR, PSQ, SSQ, 1.f / 1024.f};
        pg8::gemm_phase<pg8::EpiResBf16<false, true>, pg8::GroupedOrder, true, true>(lds + RING_OFF, g, S, E);
    }
    SEAM(5);
    if (IN(7)) {
        pg8::Gemm g{XR, WGU, M, GU_N, D, D, D}; pg8::StaticOrder S; S.init(M, GU_N, G, bx);
        pg8::EpiSwiGLU E{ACT, DFF, PSQ};
        pg8::gemm_phase<pg8::EpiSwiGLU, pg8::StaticOrder, true, true>(lds + RING_OFF, g, S, E);
        { const int nextra = S.nwg % G; if (nextra && bx >= nextra) convert_layer(k0, k1, k2, k3, k4, scr, (bx - nextra) * NWAVES + wave, (G - nextra) * NWAVES, lane, 0, L1_ITEMS_B); }
    }
    SEAM(7);
    if (IN(8)) {
        pg8::Gemm g{ACT, WDN, M, D, DFF, DFF, DFF}; pg8::StaticOrder S; S.init(M, D, G, bx);
        pg8::EpiResBf16<false, false> E{XR, XR, PSQ, nullptr};
        pg8::gemm_phase<pg8::EpiResBf16<false, false>, pg8::StaticOrder, true, true>(lds + RING_OFF, g, S, E);
    }
    if (IN(9)) {
        convert_layer(k0, k1, k2, k3, k4, scr, gw, NGW, lane, L1_ITEMS_B, wjob_items(k0) + wjob_items(k1) + wjob_items(k2) + wjob_items(k3));
        zero_rows_bf16(WIN1 + (size_t)G_IN * D, (size_t)(G_INP - G_IN) * D, vcu * 512 + tid, G * 512);
    }
    SEAM(9);
    if (IN(10)) {
        pg8::Gemm g{XR, WIN1, M, G_PROJ, D, D, D}; pg8::StaticOrder S; S.init(M, G_PROJ, G, bx);
        pg8::EpiGlaIn E{PROJ, PSQ};
        pg8::gemm_phase<pg8::EpiGlaIn, pg8::StaticOrder, true, true>(lds + RING_OFF, g, S, E);
        pg8::Gemm g2{XR, WIN1, M, 256, D / 4, D, D}; pg8::KSplitOrder S2; S2.init(M, G, bx, 48, D / 4);
        pg8::EpiGkPart E2{GKP, PSQ};
        pg8::gemm_phase<pg8::EpiGkPart, pg8::KSplitOrder, true, true>(lds + RING_OFF, g2, S2, E2);
    }
    SEAM(10);
    if (IN(11)) { for (int ch = vcu; ch < M / 64; ch += G) gla_prep_chunk(GKP, l1_gk_up, l1_gk_bias, PROJ, QD, KI, EE, PBb, lds + RING_OFF, ch, tid); __syncthreads(); }
    SEAM(11);
    if (IN(12)) {
        for (int u = bx; u < 256; u += G) { const int xcd = u & 7, j = u >> 3, pair = xcd * 2 + (j >> 4), b = pair >> 3, hh = pair & 7, sl = j & 15;
            gla_chunk_unit(lds + RING_OFF, b, hh, sl, QD, KI, PROJ, EE, PBb, Ob, SSQ2, tid); __syncthreads(); }
    }
    SEAM(12);
    if (IN(14)) {
        pg8::Gemm g{Ob, WOUT1b, M, D, 512, D, D}; pg8::GroupedOrder S; S.init(M, D, G, bx, 512);
        pg8::EpiResBf16<false, true> E{XR, XR, PSQ, SSQ2, 1.f / 512.f};
        pg8::gemm_phase<pg8::EpiResBf16<false, true>, pg8::GroupedOrder, true, true>(lds + RING_OFF, g, S, E);
    }
    SEAM(14);
    if (IN(16)) {
        pg8::Gemm g{XR, WGU1, M, GU_N, D, D, D}; pg8::StaticOrder S; S.init(M, GU_N, G, bx);
        pg8::EpiSwiGLU E{ACT, DFF, PSQ};
        pg8::gemm_phase<pg8::EpiSwiGLU, pg8::StaticOrder, true, true>(lds + RING_OFF, g, S, E);
        { const int nextra = S.nwg % G; if (nextra && bx >= nextra) convert_layer(k4, k4, k4, k4, k4, scr, (bx - nextra) * NWAVES + wave, (G - nextra) * NWAVES, lane, 0, wjob_items(k4));
          else if (!nextra) convert_layer(k4, k4, k4, k4, k4, scr, gw, NGW, lane, 0, wjob_items(k4)); }
    }
    SEAM(16);
    if (IN(17)) {
        pg8::Gemm g{ACT, WDN1, M, D, DFF, DFF, DFF}; pg8::StaticOrder S; S.init(M, D, G, bx);
        pg8::EpiResBf16<false, false> E{XR, XR, PSQ, nullptr};
        pg8::gemm_phase<pg8::EpiResBf16<false, false>, pg8::StaticOrder, true, true>(lds + RING_OFF, g, S, E);
    }
    SEAM(17);
    if (IN(18)) { for (int m = gw; m < M; m += NGW) rmsnorm_row_from_bf16(XR + (size_t)m * D, final_norm, out + (size_t)m * D, lane); }
#undef IN
#undef SEAM
}

extern "C" void kernel_launch(void* const* d_in, const int* in_sizes, int n_in, void* d_out, int out_size, void* d_ws, size_t ws_size, hipStream_t stream) {
    static int grid = 0;
    if (grid == 0) {
        if (n_in != 25 || in_sizes[0] != M * D || out_size != M * D || ws_size < WS_END) { fprintf(stderr, "kernel_launch: unexpected problem (n_in %d, in0 %d, out %d, ws %zu < %zu); nothing launched\n", n_in, n_in > 0 ? in_sizes[0] : -1, out_size, ws_size, (size_t)WS_END); grid = -1; return; }
        int dev = 0, cus = 0, per_cu = 0;
        if (hipGetDevice(&dev) != hipSuccess || hipDeviceGetAttribute(&cus, hipDeviceAttributeMultiprocessorCount, dev) != hipSuccess) { fprintf(stderr, "kernel_launch: device query failed\n"); grid = -1; return; }
        if (hipFuncSetAttribute((const void*)trunk_fwd, hipFuncAttributeMaxDynamicSharedMemorySize, LDS_BYTES) != hipSuccess) { fprintf(stderr, "kernel_launch: hipFuncSetAttribute failed\n"); grid = -1; return; }
        if (hipOccupancyMaxActiveBlocksPerMultiprocessor(&per_cu, (const void*)trunk_fwd, NWAVES * 64, LDS_BYTES) != hipSuccess || per_cu < 1)
            fprintf(stderr, "kernel_launch: note: occupancy query reports %d workgroups per CU\n", per_cu);
        (void)hipGetLastError();
        grid = cus;
    }
    if (grid < 0) return;
    if (hipMemsetAsync((char*)d_ws + WS_CTL, 0, CTL_ZERO_BYTES, stream) != hipSuccess) { fprintf(stderr, "kernel_launch: memset failed\n"); return; }
    Args a{};
    for (int i = 0; i < 25; ++i) a.in[i] = (const float*)d_in[i];
    a.out = (float*)d_out; a.ws = (unsigned char*)d_ws;
#if MK_SPLIT
    for (int p = 0; p < NPHASE; ++p) { a.ph_lo = p; a.ph_hi = p + 1; hipLaunchKernelGGL(trunk_fwd, dim3(grid), dim3(NWAVES * 64), LDS_BYTES, stream, a); }
#else
    a.ph_lo = 0; a.ph_hi = NPHASE;
    hipLaunchKernelGGL(trunk_fwd, dim3(grid), dim3(NWAVES * 64), LDS_BYTES, stream, a);
#endif
    const hipError_t le = hipPeekAtLastError();
    if (le != hipSuccess) fprintf(stderr, "kernel_launch: launch failed: %s\n", hipGetErrorName(le));
}
```
